# Optimizing an MI355X kernel written in HIP

```python
import jax, jax.numpy as jnp
from jax import lax
import numpy as np

D_MODEL = 1024
BATCH = 8
SEQ = 4096
DEPTH = 4

GRID_W = 64
CTX_LEN = 256
N_MOD = 9
RET_HEADS = 4
RET_DK = 256
RET_DV = 512
RET_CHUNK = 128
ATT_HEADS = 8
ATT_KV_HEADS = 2
ATT_HD = 128
Q_BLOCK = 128
FFN_DIM = 2816
ROPE_THETA = 10000.0
EPS = 1e-6
N_RET = (DEPTH + 1) // 2
N_ATT = DEPTH // 2
ADA_SCALE = 0.5

kernel_name = "hybrid_retention_gqa_macaron_dit"

F32 = jnp.float32


def _rms(x, g):
    xf = x.astype(F32)
    y = xf * lax.rsqrt(jnp.mean(xf * xf, axis=-1, keepdims=True) + EPS)
    return (y * g.astype(F32)).astype(x.dtype)


def _modulated(x, g, shift, scale):
    return _rms(x, g) * (1.0 + scale) + shift


def _swiglu(h, w1, w2):
    gate, up = jnp.split(h @ w1, 2, axis=-1)
    return (jax.nn.silu(gate) * up) @ w2


def _rotate(x, ang):
    half = x.shape[-1] // 2
    xf = x.astype(F32)
    x1, x2 = xf[..., :half], xf[..., half:]
    cos, sin = jnp.cos(ang), jnp.sin(ang)
    return jnp.concatenate([x1 * cos - x2 * sin, x2 * cos + x1 * sin], axis=-1).astype(x.dtype)


def _axial_angles(n_tok, dim):
    rows = n_tok // GRID_W
    r, cl = jnp.meshgrid(jnp.arange(rows), jnp.arange(GRID_W), indexing="ij")
    r = r.reshape(-1).astype(F32)
    cl = cl.reshape(-1).astype(F32)
    quarter = dim // 4
    freqs = ROPE_THETA ** (-jnp.arange(quarter, dtype=F32) / quarter)
    return jnp.concatenate([r[:, None] * freqs, cl[:, None] * freqs], axis=-1)


def _seq_angles(n_tok, dim):
    half = dim // 2
    freqs = ROPE_THETA ** (-jnp.arange(half, dtype=F32) / half)
    return jnp.arange(n_tok, dtype=F32)[:, None] * freqs


def _ret_decays(log_g, C):
    pos = jnp.arange(C, dtype=F32)
    diff = pos[:, None] - pos[None, :]
    intra = jnp.where(diff[None] >= 0, jnp.exp(jnp.maximum(diff, 0.0)[None] * log_g[:, None, None]), 0.0)
    xi = jnp.exp((pos + 1.0)[None] * log_g[:, None])
    zeta = jnp.exp((C - 1.0 - pos)[None] * log_g[:, None])
    chunk = jnp.exp(C * log_g)
    return intra, xi, zeta, chunk


def _ret_scan(q, k, v, log_g, state0):
    B, H, L, dk = q.shape
    dv = v.shape[-1]
    C = RET_CHUNK
    N = L // C
    intra, xi, zeta, chunk = _ret_decays(log_g, C)
    qc = q.reshape(B, H, N, C, dk)
    kc = k.reshape(B, H, N, C, dk)
    vc = v.reshape(B, H, N, C, dv)
    s = jnp.einsum("bhncd,bhnmd->bhncm", qc, kc) * intra[None, :, None]
    inner = jnp.einsum("bhncm,bhnme->bhnce", s, vc)
    xs = (jnp.moveaxis(qc * xi[None, :, None, :, None], 2, 0),
          jnp.moveaxis(kc * zeta[None, :, None, :, None], 2, 0),
          jnp.moveaxis(vc, 2, 0))

    def step(state, blk):
        qx, kz, vb = blk
        cross = jnp.einsum("bhcd,bhde->bhce", qx, state)
        state = state * chunk[None, :, None, None] + jnp.einsum("bhcd,bhce->bhde", kz, vb)
        return state, cross

    final, cross = lax.scan(step, state0, xs)
    out = inner + jnp.moveaxis(cross, 0, 2)
    return out.reshape(B, H, L, dv), final


def _ret_final_state(k, v, log_g):
    L = k.shape[2]
    w = jnp.exp((L - 1.0 - jnp.arange(L, dtype=F32))[None] * log_g[:, None])
    return jnp.einsum("bhld,bhle,hl->bhde", k, v, w)


def _to_heads(p, n, d):
    B, L, _ = p.shape
    return p.reshape(B, L, n, d).transpose(0, 2, 1, 3)


def _retention(h, hc, w_in, w_out, dec_f, dec_b, ctx_out):
    QD = RET_HEADS * RET_DK
    VD = RET_HEADS * RET_DV
    log_f = -jnp.exp(dec_f.astype(F32))
    log_b = -jnp.exp(dec_b.astype(F32))
    flip = lambda a: a[:, :, ::-1]

    def qkvg(z):
        p = (z @ w_in).astype(F32)
        q, k, v, g = jnp.split(p, [QD, 2 * QD, 2 * QD + VD], axis=-1)
        return (_to_heads(q, RET_HEADS, RET_DK), _to_heads(k, RET_HEADS, RET_DK) * RET_DK ** -0.5,
                _to_heads(v, RET_HEADS, RET_DV), g)

    def merge(o, g):
        o = o * lax.rsqrt(jnp.mean(o * o, axis=-1, keepdims=True) + EPS)
        B, H, L, dv = o.shape
        o = o.transpose(0, 2, 1, 3).reshape(B, L, H * dv)
        return ((o * jax.nn.silu(g)) @ w_out).astype(h.dtype)

    B, L, _ = h.shape
    q, k, v, g = qkvg(h)
    ang = _seq_angles(L, RET_DK)
    q = _rotate(q, ang)
    k = _rotate(k, ang)

    if ctx_out:
        qc, kc, vc, gc = qkvg(hc)
        zeros = jnp.zeros((B, RET_HEADS, RET_DK, RET_DV), F32)
        oc_f, s_f = _ret_scan(qc, kc, vc, log_f, zeros)
        oc_b, s_b = _ret_scan(flip(qc), flip(kc), flip(vc), log_b, zeros)
        yc = merge(oc_f + flip(oc_b), gc)
    else:
        p = (hc @ w_in[:, QD:2 * QD + VD]).astype(F32)
        kc = _to_heads(p[..., :QD], RET_HEADS, RET_DK) * RET_DK ** -0.5
        vc = _to_heads(p[..., QD:], RET_HEADS, RET_DV)
        s_f = _ret_final_state(kc, vc, log_f)
        s_b = _ret_final_state(flip(kc), flip(vc), log_b)
        yc = None

    o_f, _ = _ret_scan(q, k, v, log_f, s_f)
    o_b, _ = _ret_scan(flip(q), flip(k), flip(v), log_b, s_b)
    y = merge(o_f + flip(o_b), g)
    return y, yc


def _attend(q, k, v):
    s = jnp.einsum("bkgqd,bksd->bkgqs", q, k).astype(F32) * ATT_HD ** -0.5
    p = jax.nn.softmax(s, axis=-1)
    return jnp.einsum("bkgqs,bksd->bkgqd", p.astype(v.dtype), v)


def _gqa(h, hc, w_qkv, w_o, q_gain, k_gain, ctx_out):
    QD = ATT_HEADS * ATT_HD
    KD = ATT_KV_HEADS * ATT_HD
    G = ATT_HEADS // ATT_KV_HEADS

    def kv(p):
        k = _rms(_to_heads(p[..., :KD], ATT_KV_HEADS, ATT_HD), k_gain)
        v = _to_heads(p[..., KD:], ATT_KV_HEADS, ATT_HD)
        return k, v

    def merge(o):
        B, _, _, L, _ = o.shape
        return o.reshape(B, ATT_HEADS, L, ATT_HD).transpose(0, 2, 1, 3).reshape(B, L, QD) @ w_o

    B, L, _ = h.shape
    p = h @ w_qkv
    q = _rms(_to_heads(p[..., :QD], ATT_HEADS, ATT_HD), q_gain)
    k, v = kv(p[..., QD:])
    ang = _axial_angles(L, ATT_HD)
    q = _rotate(q, ang)
    k = _rotate(k, ang)

    if ctx_out:
        pc = hc @ w_qkv
        qc = _rms(_to_heads(pc[..., :QD], ATT_HEADS, ATT_HD), q_gain)
        kc, vc = kv(pc[..., QD:])
        Lc = hc.shape[1]
        yc = merge(_attend(qc.reshape(B, ATT_KV_HEADS, G, Lc, ATT_HD), kc, vc))
    else:
        kc, vc = kv(hc @ w_qkv[:, QD:])
        yc = None

    k_all = jnp.concatenate([k, kc], axis=2)
    v_all = jnp.concatenate([v, vc], axis=2)
    NB = L // Q_BLOCK
    qb = jnp.moveaxis(q.reshape(B, ATT_KV_HEADS, G, NB, Q_BLOCK, ATT_HD), 3, 0)
    o = lax.map(lambda qi: _attend(qi, k_all, v_all), qb)
    o = jnp.moveaxis(o, 0, 3).reshape(B, ATT_KV_HEADS, G, L, ATT_HD)
    return merge(o), yc


def setup_inputs(seed: int = 0) -> dict:
    key = jax.random.key(seed)
    ks = jax.random.split(key, 20)
    D = D_MODEL
    nrm = lambda k, shp, fan: jax.random.normal(k, shp, F32) * fan ** -0.5
    ret_in = RET_HEADS * (2 * RET_DK + 2 * RET_DV)
    att_in = (ATT_HEADS + 2 * ATT_KV_HEADS) * ATT_HD
    base = jnp.log(-jnp.log1p(-(2.0 ** (-5.0 - jnp.arange(RET_HEADS, dtype=F32)))))
    return {
        "x": jax.random.normal(ks[0], (BATCH, SEQ, D), F32),
        "c": jax.random.normal(ks[1], (BATCH, D), F32),
        "ctx": jax.random.normal(ks[2], (BATCH, CTX_LEN, D), F32),
        "c_ctx": jax.random.normal(ks[3], (D,), F32),
        "ada_w": nrm(ks[4], (DEPTH, D, N_MOD * D), D) * ADA_SCALE,
        "ada_b": 0.01 * jax.random.normal(ks[5], (DEPTH, N_MOD * D), F32),
        "norm_g": 1.0 + 0.02 * jax.random.normal(ks[6], (DEPTH, 3, D), F32),
        "ffn_w1": nrm(ks[7], (DEPTH, 2, D, 2 * FFN_DIM), D),
        "ffn_w2": nrm(ks[8], (DEPTH, 2, FFN_DIM, D), FFN_DIM),
        "ret_w_in": nrm(ks[9], (N_RET, D, ret_in), D),
        "ret_w_out": nrm(ks[10], (N_RET, RET_HEADS * RET_DV, D), RET_HEADS * RET_DV),
        "ret_decay_f": base[None] + 0.01 * jax.random.normal(ks[11], (N_RET, RET_HEADS), F32),
        "ret_decay_b": base[None] + 0.01 * jax.random.normal(ks[12], (N_RET, RET_HEADS), F32),
        "att_w_qkv": nrm(ks[13], (N_ATT, D, att_in), D),
        "att_w_o": nrm(ks[14], (N_ATT, ATT_HEADS * ATT_HD, D), ATT_HEADS * ATT_HD),
        "att_q_gain": 1.0 + 0.02 * jax.random.normal(ks[15], (N_ATT, ATT_HD), F32),
        "att_k_gain": 1.0 + 0.02 * jax.random.normal(ks[16], (N_ATT, ATT_HD), F32),
        "final_g": 1.0 + 0.02 * jax.random.normal(ks[17], (D,), F32),
    }


def reference(x, c, ctx, c_ctx, ada_w, ada_b, norm_g, ffn_w1, ffn_w2, ret_w_in, ret_w_out,
              ret_decay_f, ret_decay_b, att_w_qkv, att_w_o, att_q_gain, att_k_gain, final_g):
    xc = ctx
    sc = jax.nn.silu(c)
    scc = jax.nn.silu(c_ctx)
    for i in range(DEPTH):
        last = i == DEPTH - 1
        m = jnp.split((sc @ ada_w[i] + ada_b[i])[:, None, :], N_MOD, axis=-1)
        mc = jnp.split(scc @ ada_w[i] + ada_b[i], N_MOD, axis=-1)
        x = x + 0.5 * m[2] * _swiglu(_modulated(x, norm_g[i, 0], m[0], m[1]), ffn_w1[i, 0], ffn_w2[i, 0])
        xc = xc + 0.5 * mc[2] * _swiglu(_modulated(xc, norm_g[i, 0], mc[0], mc[1]), ffn_w1[i, 0], ffn_w2[i, 0])
        h = _modulated(x, norm_g[i, 1], m[3], m[4])
        hc = _modulated(xc, norm_g[i, 1], mc[3], mc[4])
        j = i // 2
        if i % 2 == 0:
            y, yc = _retention(h, hc, ret_w_in[j], ret_w_out[j], ret_decay_f[j], ret_decay_b[j], not last)
        else:
            y, yc = _gqa(h, hc, att_w_qkv[j], att_w_o[j], att_q_gain[j], att_k_gain[j], not last)
        x = x + m[5] * y
        if not last:
            xc = xc + mc[5] * yc
            xc = xc + 0.5 * mc[8] * _swiglu(_modulated(xc, norm_g[i, 2], mc[6], mc[7]), ffn_w1[i, 1], ffn_w2[i, 1])
        x = x + 0.5 * m[8] * _swiglu(_modulated(x, norm_g[i, 2], m[6], m[7]), ffn_w1[i, 1], ffn_w2[i, 1])
    return _rms(x, final_g)
```

```cpp
#include <hip/hip_runtime.h>
#include <hip/hip_cooperative_groups.h>
#include <hip/hip_bf16.h>
#include <cstdio>
#include <cstdint>
namespace cg = cooperative_groups;
__device__ __forceinline__ int otid() { int t = threadIdx.x; asm volatile("" : "+v"(t)); return t; }
__device__ __forceinline__ int obid() { int t = blockIdx.x; asm volatile("" : "+s"(t)); return t; }
__device__ __forceinline__ int ogrid() { int t = gridDim.x; asm volatile("" : "+s"(t)); return t; }
namespace pg8 {
#define PG8_LAS __attribute__((address_space(3)))
typedef unsigned short bf16_t;
typedef short bf16x8 __attribute__((ext_vector_type(8)));
typedef float f32x4 __attribute__((ext_vector_type(4)));
typedef unsigned u32x4 __attribute__((ext_vector_type(4)));
constexpr int BM = 256, BK = 64, HALF = 128, HTB = HALF * BK * 2  , STAGE_BYTES = 8 * HTB, NXCD = 8, WGM = 8;

__host__ __device__ __forceinline__ int lds_byte(int r, int c) { const int st = (r >> 4) * 2 + (c >> 5), rr = r & 15, cc = c & 31, ob = rr * 64 + cc * 2; return st * 1024 + (ob ^ (((ob >> 9) & 1) << 5)); }
__host__ __device__ __forceinline__ void stage_rc(int b, int& R, int& C) { const int st = b / 1024, sb = b % 1024, swz = sb ^ (((sb >> 9) & 1) << 5); R = (st >> 1) * 16 + swz / 64; C = (st & 1) * 32 + (swz % 64) / 2; }
__host__ __device__ __forceinline__ int perm32(int rho) { const int n = rho >> 4, i = rho & 15; return 8 * (i >> 2) + 4 * n + (i & 3); }

struct Unit { int pm, pn, kb; };
struct Gemm { const bf16_t* A; const bf16_t* Bt; int M, N, K, Kl; };

struct StaticOrder {
    int nM, nN, nwg, G, c;
    __host__ __device__ void init(int M, int N, int G_, int c_) { nM = M / BM; nN = N / BM; nwg = nM * nN; G = G_; c = c_; }
    __host__ __device__ bool next(int i, Unit& u) const {
        const long L = (long)i * G + c; if (L >= nwg) return false;
        int wgid = (int)L; { const int q = nwg / NXCD, r = nwg % NXCD, xcd = wgid % NXCD, off = wgid / NXCD; wgid = (xcd < r ? xcd * (q + 1) : r * (q + 1) + (xcd - r) * q) + off; }
        const int nig = WGM * nN, gid = wgid / nig, fm = gid * WGM, gsz = (nM - fm) < WGM ? (nM - fm) : WGM;
        u.pm = fm + ((wgid % nig) % gsz); u.pn = (wgid % nig) / gsz; u.kb = 0; return true;
    }
    __device__ __forceinline__ void a_ready(const Unit&) const {}
    __device__ __forceinline__ void done(const Unit&) const {}
};

struct LatentOrder {
    StaticOrder so;
    __host__ __device__ void init(int Mtiles_all, int N, int G_, int c_) { so.init((Mtiles_all / 17) * 16 * BM, N, G_, c_); }
    __host__ __device__ bool next(int i, Unit& u) const { if (!so.next(i, u)) return false; u.pm = u.pm + (u.pm >> 4); return true; }
    __device__ __forceinline__ void a_ready(const Unit&) const {}
    __device__ __forceinline__ void done(const Unit&) const {}
};
struct CtxSplitOrder {
    int nctx, nN, nks, klb, G, c;
    __host__ __device__ void init(int Mtiles_all, int N, int K, int kl, int G_, int c_) { nctx = Mtiles_all / 17; nN = N / BM; nks = K / kl; klb = kl * 2; G = G_; c = c_; }
    __host__ __device__ bool next(int i, Unit& u) const {
        const int L = i * G + c; const int per = nctx * nN; if (L >= per * nks) return false;
        const int ks = L / per, t = L - ks * per; u.pn = t % nN; u.pm = 17 * (t / nN) + 16; u.kb = ks * klb; return true;
    }
    __device__ __forceinline__ void a_ready(const Unit&) const {}
    __device__ __forceinline__ void done(const Unit&) const {}
};
__device__ __forceinline__ unsigned cvt_pk_bf16(float lo, float hi) { unsigned r; asm volatile("v_cvt_pk_bf16_f32 %0, %1, %2" : "=v"(r) : "v"(lo), "v"(hi)); return r; }
typedef float f32x2 __attribute__((ext_vector_type(2)));
constexpr int DM = 1024, NBATCH = 8, SEQ = 4096, CTXL = 256, RPB = SEQ + CTXL, MR = NBATCH * RPB, MH = MR / 2, TPB = RPB / 256, HTILES = MH / 256;
constexpr int FFD = 2816, NMODW = 9 * DM;
__device__ __forceinline__ float bf2f(unsigned short s) { return __uint_as_float(((unsigned)s) << 16); }
__device__ __forceinline__ float fast_silu(float x) { return x * __builtin_amdgcn_rcpf(1.0f + __builtin_amdgcn_exp2f(-1.4426950408889634f * x)); }

struct EpiSwiglu {
    static constexpr bool PERM = true, AFTER_DRAIN = false;
    bf16_t* H;
    __device__ __forceinline__ void operator()(const f32x4 (&acc)[2][2][4][2], const Unit& u, int wr, int wc, int fr, int fq) const {
        const int row0 = u.pm * BM + wr * 64 + fr; const int col0 = u.pn * HALF + wc * 32 + 8 * fq;
#pragma unroll
        for (int ai = 0; ai < 2; ++ai)
#pragma unroll
            for (int m = 0; m < 4; ++m) {
                bf16_t* rowp = H + (size_t)(row0 + ai * HALF + m * 16) * FFD + col0;
                const f32x4 g0 = acc[ai][0][m][0], g1 = acc[ai][0][m][1], u0 = acc[ai][1][m][0], u1 = acc[ai][1][m][1];
                u32x4 w;
                w.x = cvt_pk_bf16(fast_silu(g0[0]) * u0[0], fast_silu(g0[1]) * u0[1]); w.y = cvt_pk_bf16(fast_silu(g0[2]) * u0[2], fast_silu(g0[3]) * u0[3]);
                w.z = cvt_pk_bf16(fast_silu(g1[0]) * u1[0], fast_silu(g1[1]) * u1[1]); w.w = cvt_pk_bf16(fast_silu(g1[2]) * u1[2], fast_silu(g1[3]) * u1[3]);
                *(u32x4*)rowp = w;
            }
    }
};
struct EpiResid {
    static constexpr bool PERM = true, AFTER_DRAIN = false;
    float* X; const float* gate  ; float gs; int pm_off;
    __device__ __forceinline__ void operator()(const f32x4 (&acc)[2][2][4][2], const Unit& u, int wr, int wc, int fr, int fq) const {
        const int pmg = u.pm + pm_off; const int bb = pmg / TPB, within = pmg - bb * TPB; const int mrow = (within == TPB - 1) ? 8 : bb;
        const int col0 = u.pn * BM + wc * 32 + 8 * fq; const float* gp = gate + (size_t)mrow * NMODW + col0;
        f32x4 gv[2][2];
#pragma unroll
        for (int bj = 0; bj < 2; ++bj)
#pragma unroll
            for (int n = 0; n < 2; ++n) gv[bj][n] = *(const f32x4*)(gp + bj * HALF + n * 4) * gs;
        const int row0 = pmg * BM + wr * 64 + fr;
#pragma unroll
        for (int ai = 0; ai < 2; ++ai)
#pragma unroll
            for (int m = 0; m < 4; ++m) {
                float* rowp = X + (size_t)(row0 + ai * HALF + m * 16) * DM + col0;
#pragma unroll
                for (int bj = 0; bj < 2; ++bj)
#pragma unroll
                    for (int n = 0; n < 2; ++n) { f32x4* p = (f32x4*)(rowp + bj * HALF + n * 4); *p = *p + gv[bj][n] * acc[ai][bj][m][n]; }
            }
    }
};
struct EpiPartial {
    static constexpr bool PERM = true, AFTER_DRAIN = false;
    float* P; int klb, nrows;
    __device__ __forceinline__ void operator()(const f32x4 (&acc)[2][2][4][2], const Unit& u, int wr, int wc, int fr, int fq) const {
        const int ks = u.kb / klb, ci = u.pm / TPB; const int col0 = u.pn * BM + wc * 32 + 8 * fq;
        float* base = P + ((size_t)ks * nrows + ci * BM + wr * 64 + fr) * DM + col0;
#pragma unroll
        for (int ai = 0; ai < 2; ++ai)
#pragma unroll
            for (int m = 0; m < 4; ++m) { float* rowp = base + (size_t)(ai * HALF + m * 16) * DM;
#pragma unroll
                for (int bj = 0; bj < 2; ++bj) { *(f32x4*)(rowp + bj * HALF) = acc[ai][bj][m][0]; *(f32x4*)(rowp + bj * HALF + 4) = acc[ai][bj][m][1]; } }
    }
};
struct EpiPlain {
    static constexpr bool PERM = true, AFTER_DRAIN = false;
    bf16_t* O; int ldc;
    __device__ __forceinline__ void operator()(const f32x4 (&acc)[2][2][4][2], const Unit& u, int wr, int wc, int fr, int fq) const {
        const int row0 = u.pm * BM + wr * 64 + fr; const int col0 = u.pn * BM + wc * 32 + 8 * fq;
#pragma unroll
        for (int ai = 0; ai < 2; ++ai)
#pragma unroll
            for (int m = 0; m < 4; ++m) { bf16_t* rowp = O + (size_t)(row0 + ai * HALF + m * 16) * ldc + col0;
#pragma unroll
                for (int bj = 0; bj < 2; ++bj) { const f32x4 v0 = acc[ai][bj][m][0], v1 = acc[ai][bj][m][1]; u32x4 w;
                    w.x = cvt_pk_bf16(v0[0], v0[1]); w.y = cvt_pk_bf16(v0[2], v0[3]); w.z = cvt_pk_bf16(v1[0], v1[1]); w.w = cvt_pk_bf16(v1[2], v1[3]);
                    *(u32x4*)(rowp + bj * HALF) = w; } }
    }
};
struct EpiRetQKG {
    static constexpr bool PERM = true, AFTER_DRAIN = false;
    bf16_t* O; const float* cosR; const float* sinR;   int pm_off;
    __device__ __forceinline__ void operator()(const f32x4 (&acc)[2][2][4][2], const Unit& u, int wr, int wc, int fr, int fq) const {
        const int pmg = u.pm + pm_off; const int bb = pmg / TPB, within = pmg - bb * TPB; const bool latent = within < TPB - 1;
        const int row0 = u.pm * BM + wr * 64 + fr; const int jc = wc * 32 + 8 * fq; const int col0 = u.pn * BM + jc;
        const bool isg = u.pn >= 8;
#pragma unroll
        for (int ai = 0; ai < 2; ++ai)
#pragma unroll
            for (int m = 0; m < 4; ++m) {
                const int rl = ai * HALF + wr * 64 + m * 16 + fr;
                bf16_t* rowp = O + (size_t)(u.pm * BM + rl) * 4096 + col0;
                f32x4 a0 = acc[ai][0][m][0], a1 = acc[ai][0][m][1], b0 = acc[ai][1][m][0], b1 = acc[ai][1][m][1];
                if (isg) {
#pragma unroll
                    for (int i = 0; i < 4; ++i) { a0[i] = fast_silu(a0[i]); a1[i] = fast_silu(a1[i]); b0[i] = fast_silu(b0[i]); b1[i] = fast_silu(b1[i]); }
                } else if (latent) {
                    const int pos = within * BM + rl;
                    const f32x4 c0 = *(const f32x4*)(cosR + (size_t)pos * 128 + jc), c1 = *(const f32x4*)(cosR + (size_t)pos * 128 + jc + 4);
                    const f32x4 s0 = *(const f32x4*)(sinR + (size_t)pos * 128 + jc), s1 = *(const f32x4*)(sinR + (size_t)pos * 128 + jc + 4);
                    const f32x4 x0 = a0 * c0 - b0 * s0, y0 = b0 * c0 + a0 * s0, x1 = a1 * c1 - b1 * s1, y1 = b1 * c1 + a1 * s1;
                    a0 = x0; b0 = y0; a1 = x1; b1 = y1;
                }
                u32x4 w; w.x = cvt_pk_bf16(a0[0], a0[1]); w.y = cvt_pk_bf16(a0[2], a0[3]); w.z = cvt_pk_bf16(a1[0], a1[1]); w.w = cvt_pk_bf16(a1[2], a1[3]);
                *(u32x4*)rowp = w;
                w.x = cvt_pk_bf16(b0[0], b0[1]); w.y = cvt_pk_bf16(b0[2], b0[3]); w.z = cvt_pk_bf16(b1[0], b1[1]); w.w = cvt_pk_bf16(b1[2], b1[3]);
                *(u32x4*)(rowp + HALF) = w;
            }
        (void)row0;
    }
};
struct EpiRetKVT {
    static constexpr bool PERM = true, AFTER_DRAIN = false;
    bf16_t* O; const float* cosT; const float* sinT;   int pn_off;
    __device__ __forceinline__ void operator()(const f32x4 (&acc)[2][2][4][2], const Unit& u, int wr, int wc, int fr, int fq) const {
        const int png = u.pn + pn_off; const int bb = png / TPB, within = png - bb * TPB; const bool rot = (within < TPB - 1) && (u.pm < 4);
        const int tc = wc * 32 + 8 * fq;
#pragma unroll
        for (int m = 0; m < 4; ++m) {
            const int j = wr * 64 + m * 16 + fr;
#pragma unroll
            for (int bj = 0; bj < 2; ++bj) {
                f32x4 a0 = acc[0][bj][m][0], a1 = acc[0][bj][m][1], b0 = acc[1][bj][m][0], b1 = acc[1][bj][m][1];
                if (rot) {
                    const int pos = within * BM + bj * HALF + tc;
                    const f32x4 c0 = *(const f32x4*)(cosT + (size_t)j * SEQ + pos), c1 = *(const f32x4*)(cosT + (size_t)j * SEQ + pos + 4);
                    const f32x4 s0 = *(const f32x4*)(sinT + (size_t)j * SEQ + pos), s1 = *(const f32x4*)(sinT + (size_t)j * SEQ + pos + 4);
                    const f32x4 x0 = a0 * c0 - b0 * s0, y0 = b0 * c0 + a0 * s0, x1 = a1 * c1 - b1 * s1, y1 = b1 * c1 + a1 * s1;
                    a0 = x0; b0 = y0; a1 = x1; b1 = y1;
                }
                bf16_t* p0 = O + (size_t)(u.pm * BM + j) * MH + u.pn * BM + bj * HALF + tc;
                u32x4 w; w.x = cvt_pk_bf16(a0[0], a0[1]); w.y = cvt_pk_bf16(a0[2], a0[3]); w.z = cvt_pk_bf16(a1[0], a1[1]); w.w = cvt_pk_bf16(a1[2], a1[3]);
                *(u32x4*)p0 = w;
                w.x = cvt_pk_bf16(b0[0], b0[1]); w.y = cvt_pk_bf16(b0[2], b0[3]); w.z = cvt_pk_bf16(b1[0], b1[1]); w.w = cvt_pk_bf16(b1[2], b1[3]);
                *(u32x4*)(p0 + (size_t)HALF * MH) = w;
            }
        }
    }
};
template <class Epi, class Sched, bool ALIGN_EPI = false, bool SP2 = false>
__device__ __forceinline__ void gemm_phase(PG8_LAS unsigned char* lds, const Gemm g, const Sched& S, const Epi& E) {
    const int tid = otid(), wid = __builtin_amdgcn_readfirstlane(tid >> 6), lane = tid & 63, wr = wid >> 2, wc = wid & 3, fr = lane & 15, fq = lane >> 4;
    const int K = g.K, nt = g.Kl / BK;
    unsigned voffA[2], voffB[2];
#pragma unroll
    for (int i = 0; i < 2; ++i) { int R, C; stage_rc(tid * 16 + i * 8192, R, C); const int Rb = Epi::PERM ? ((R & ~31) + perm32(R & 31)) : R;
        voffA[i] = (unsigned)(R * K + C) * 2u; voffB[i] = (unsigned)(Rb * K + C) * 2u; }
    const size_t kstep = (size_t)(BK * 2);
    const size_t hstep = (size_t)HALF * K * 2;
    const size_t tstep = 2 * hstep;
    const unsigned ldsw = (unsigned)wid * 1024u;
    const int aoff = lds_byte(wr * 64 + fr, fq * 8), boff = lds_byte(wc * 32 + fr, fq * 8);
#define PG8_SA(b, h) (((b) * 2 + (h)) * HTB)
#define PG8_SB(b, h) ((4 + (b) * 2 + (h)) * HTB)
#define PG8_STAGE(bufoff, gbase, voff) do { _Pragma("unroll") for (int _i = 0; _i < 2; ++_i) \
        __builtin_amdgcn_global_load_lds((const unsigned*)((const char*)(gbase) + (voff)[_i]), (PG8_LAS unsigned*)(lds + (bufoff) + ldsw + _i * 8192), 16, 0, 0); } while (0)
#define PG8_LDA(dst, b, h) do { _Pragma("unroll") for (int m = 0; m < 4; ++m) _Pragma("unroll") for (int k = 0; k < 2; ++k) dst[m][k] = *(const PG8_LAS bf16x8*)(lds + PG8_SA(b, h) + aoff + m * 2048 + k * 1024); } while (0)
#define PG8_LDB(dst, b, h) do { _Pragma("unroll") for (int n = 0; n < 2; ++n) _Pragma("unroll") for (int k = 0; k < 2; ++k) dst[n][k] = *(const PG8_LAS bf16x8*)(lds + PG8_SB(b, h) + boff + n * 2048 + k * 1024); } while (0)
#define PG8_MMA(ai, bj, At, Bt) do { __builtin_amdgcn_s_setprio(1); _Pragma("unroll") for (int m = 0; m < 4; ++m) _Pragma("unroll") for (int n = 0; n < 2; ++n) _Pragma("unroll") for (int k = 0; k < 2; ++k) \
        acc[ai][bj][m][n] = __builtin_amdgcn_mfma_f32_16x16x32_bf16(Bt[n][k], At[m][k], acc[ai][bj][m][n], 0, 0, 0); __builtin_amdgcn_s_setprio(0); } while (0)
#define PG8_WAIT_V(n) asm volatile("s_waitcnt vmcnt(" #n ")" ::: "memory")
#define PG8_WAIT_L(n) asm volatile("s_waitcnt lgkmcnt(" #n ")" ::: "memory")
#define PG8_BAR __builtin_amdgcn_s_barrier()
#define PG8_SCHED __builtin_amdgcn_sched_barrier(0)
    Unit cur, nxt; int ui = 0;
    if (!S.next(0, cur)) return;
    f32x4 acc[2][2][4][2];
#pragma unroll
    for (int a = 0; a < 2; ++a)
#pragma unroll
        for (int b = 0; b < 2; ++b)
#pragma unroll
            for (int m = 0; m < 4; ++m)
#pragma unroll
                for (int n = 0; n < 2; ++n) acc[a][b][m][n] = (f32x4){0.f, 0.f, 0.f, 0.f};
    bf16x8 At[4][2], B0[2][2], B1[2][2];
    const char* cA = (const char*)g.A + (size_t)cur.pm * tstep + cur.kb; const char* cB = (const char*)g.Bt + (size_t)cur.pn * tstep + cur.kb;
    S.a_ready(cur);
    if constexpr (SP2) {
        PG8_STAGE(PG8_SB(0, 0), cB, voffB); PG8_STAGE(PG8_SB(0, 1), cB + hstep, voffB); PG8_STAGE(PG8_SA(0, 0), cA, voffA); PG8_STAGE(PG8_SA(0, 1), cA + hstep, voffA);
        if (wr == 1) PG8_BAR;
        PG8_WAIT_V(2); PG8_BAR;
        PG8_STAGE(PG8_SB(1, 0), cB + kstep, voffB); PG8_STAGE(PG8_SA(1, 0), cA + kstep, voffA); PG8_STAGE(PG8_SB(1, 1), cB + hstep + kstep, voffB);
        PG8_WAIT_V(6); PG8_BAR;
    } else {
        PG8_STAGE(PG8_SB(0, 0), cB, voffB); PG8_STAGE(PG8_SA(0, 0), cA, voffA); PG8_STAGE(PG8_SB(0, 1), cB + hstep, voffB); PG8_STAGE(PG8_SA(0, 1), cA + hstep, voffA);
        if (wr == 1) PG8_BAR;
        PG8_WAIT_V(4); PG8_BAR;
        PG8_STAGE(PG8_SB(1, 0), cB + kstep, voffB); PG8_STAGE(PG8_SA(1, 0), cA + kstep, voffA); PG8_STAGE(PG8_SB(1, 1), cB + hstep + kstep, voffB);
        PG8_WAIT_V(6); PG8_BAR;
    }
    for (;;) {
        const bool has_next = S.next(ui + 1, nxt);
        const char* nA = has_next ? (const char*)g.A + (size_t)nxt.pm * tstep + nxt.kb : cA; const char* nB = has_next ? (const char*)g.Bt + (size_t)nxt.pn * tstep + nxt.kb : cB;
        for (int t = 0; t < nt; t += 2) {
            const bool last = (t == nt - 2);
            const char* a1 = cA + (size_t)(t + 1) * kstep;
            const char* a2 = last ? nA : cA + (size_t)(t + 2) * kstep; const char* b2 = last ? nB : cB + (size_t)(t + 2) * kstep;
            const char* a3 = a2 + kstep; const char* b3 = b2 + kstep;
            if (last && has_next) S.a_ready(nxt);
            if constexpr (SP2) {
            PG8_LDB(B0, 0, 0); PG8_LDB(B1, 0, 1); PG8_SCHED; PG8_LDA(At, 0, 0); PG8_STAGE(PG8_SA(1, 1), a1 + hstep, voffA);
            PG8_WAIT_V(8); PG8_WAIT_L(0); PG8_BAR; PG8_MMA(0, 0, At, B0); PG8_MMA(0, 1, At, B1); PG8_BAR; PG8_SCHED;
            PG8_LDA(At, 0, 1); PG8_STAGE(PG8_SB(0, 0), b2, voffB); PG8_STAGE(PG8_SB(0, 1), b2 + hstep, voffB); PG8_STAGE(PG8_SA(0, 0), a2, voffA);
            PG8_WAIT_V(8); PG8_WAIT_L(0); PG8_BAR; PG8_MMA(1, 0, At, B0); PG8_MMA(1, 1, At, B1); PG8_BAR; PG8_SCHED;
            PG8_LDB(B0, 1, 0); PG8_LDB(B1, 1, 1); PG8_SCHED; PG8_LDA(At, 1, 0); PG8_STAGE(PG8_SA(0, 1), a2 + hstep, voffA);
            PG8_WAIT_V(8); PG8_WAIT_L(0); PG8_BAR; PG8_MMA(0, 0, At, B0); PG8_MMA(0, 1, At, B1); PG8_BAR; PG8_SCHED;
            PG8_LDA(At, 1, 1); PG8_STAGE(PG8_SB(1, 0), b3, voffB); PG8_STAGE(PG8_SB(1, 1), b3 + hstep, voffB); PG8_STAGE(PG8_SA(1, 0), a3, voffA);
            PG8_WAIT_V(8); PG8_WAIT_L(0); PG8_BAR; PG8_MMA(1, 0, At, B0); PG8_MMA(1, 1, At, B1); PG8_BAR; PG8_SCHED;
            } else {
            PG8_LDB(B0, 0, 0); PG8_SCHED; PG8_LDA(At, 0, 0); PG8_STAGE(PG8_SA(1, 1), a1 + hstep, voffA);
            PG8_WAIT_L(8); PG8_BAR; PG8_WAIT_L(0); PG8_MMA(0, 0, At, B0); PG8_BAR; PG8_SCHED;
            PG8_LDB(B1, 0, 1); PG8_STAGE(PG8_SB(0, 0), b2, voffB);
            PG8_BAR; PG8_WAIT_L(0); PG8_MMA(0, 1, At, B1); PG8_BAR;
            PG8_LDA(At, 0, 1); PG8_STAGE(PG8_SA(0, 0), a2, voffA);
            PG8_BAR; PG8_WAIT_L(0); PG8_MMA(1, 0, At, B0); PG8_BAR; PG8_SCHED;
            PG8_STAGE(PG8_SB(0, 1), b2 + hstep, voffB);
            PG8_WAIT_V(6); PG8_BAR; PG8_MMA(1, 1, At, B1); PG8_BAR;
            PG8_LDB(B0, 1, 0); PG8_SCHED; PG8_LDA(At, 1, 0); PG8_STAGE(PG8_SA(0, 1), a2 + hstep, voffA);
            PG8_WAIT_L(8); PG8_BAR; PG8_WAIT_L(0); PG8_MMA(0, 0, At, B0); PG8_BAR; PG8_SCHED;
            PG8_LDB(B1, 1, 1); PG8_STAGE(PG8_SB(1, 0), b3, voffB);
            PG8_BAR; PG8_WAIT_L(0); PG8_MMA(0, 1, At, B1); PG8_BAR;
            PG8_LDA(At, 1, 1); PG8_STAGE(PG8_SA(1, 0), a3, voffA);
            PG8_BAR; PG8_WAIT_L(0); PG8_MMA(1, 0, At, B0); PG8_BAR; PG8_SCHED;
            PG8_STAGE(PG8_SB(1, 1), b3 + hstep, voffB);
            PG8_WAIT_V(6); PG8_BAR; PG8_MMA(1, 1, At, B1); PG8_BAR;
            }
        }
        if constexpr (ALIGN_EPI) { if (wr == 0) PG8_BAR; }
        if constexpr (!Epi::AFTER_DRAIN) { E(acc, cur, wr, wc, fr, fq); S.done(cur); }
        if (!has_next) break;
#pragma unroll
        for (int a = 0; a < 2; ++a)
#pragma unroll
            for (int b = 0; b < 2; ++b)
#pragma unroll
                for (int m = 0; m < 4; ++m)
#pragma unroll
                    for (int n = 0; n < 2; ++n) acc[a][b][m][n] = (f32x4){0.f, 0.f, 0.f, 0.f};
        cur = nxt; cA = nA; cB = nB; ++ui;
        if constexpr (ALIGN_EPI) { if (wr == 1) PG8_BAR; }
    }
    PG8_WAIT_V(0);
    if constexpr (!ALIGN_EPI) { if (wr == 0) PG8_BAR; }
    PG8_BAR;
    if constexpr (Epi::AFTER_DRAIN) { E.fused(acc, cur, wr, wc, fr, fq, lds, wid, lane); S.done(cur); }
#undef PG8_SA
#undef PG8_SB
#undef PG8_STAGE
#undef PG8_LDA
#undef PG8_LDB
#undef PG8_MMA
#undef PG8_WAIT_V
#undef PG8_WAIT_L
#undef PG8_BAR
#undef PG8_SCHED
}
}

namespace attn {
using bf16 = __hip_bfloat16;
constexpr int D = 128, NW = 8, QBLK = 32, KVBLK = 64;
constexpr float SCALE = 0.088388347648318440f;
constexpr float THR = 8.f;
constexpr int LDQ = 1536, LDK = 1536, LDO = 1024;
constexpr size_t SHM_V = KVBLK * D * 2, SHM_K = KVBLK * D * 2, SHM_ATTN = 2 * SHM_V + 2 * SHM_K + NW * 64 * 4;
using bf16x8 = __attribute__((ext_vector_type(8))) short;
using s16x4  = __attribute__((ext_vector_type(4))) short;
using f32x16 = __attribute__((ext_vector_type(16))) float;
using u32x4  = __attribute__((ext_vector_type(4))) unsigned;
#define KSWZ(row, colB) ((row) * 256 + ((colB) ^ (((row) & 7) << 4)))
#define SBAR() __builtin_amdgcn_sched_barrier(0)
__device__ __forceinline__ int crow(int r, int hi) { return (r & 3) + 8 * (r >> 2) + 4 * hi; }
__device__ __forceinline__ unsigned cvtpk(float lo, float hi) { unsigned r; asm volatile("v_cvt_pk_bf16_f32 %0, %1, %2" : "=v"(r) : "v"(lo), "v"(hi)); return r; }
__device__ __forceinline__ void partialSM(f32x16& p0, f32x16& p1, float& m_reg, float& mn, float& alpha) {
  constexpr float C = SCALE * 1.4426950408889634f;
  float pmax = p0[0]; for (int r = 1; r < 16; ++r) pmax = fmaxf(pmax, p0[r]); for (int r = 0; r < 16; ++r) pmax = fmaxf(pmax, p1[r]);
  { auto rr = __builtin_amdgcn_permlane32_swap(__float_as_uint(pmax), __float_as_uint(pmax), false, false);
    pmax = fmaxf(__uint_as_float(rr[0]), __uint_as_float(rr[1])); }
  if (__builtin_expect(__all(pmax - m_reg <= THR / SCALE), 1)) { mn = m_reg; alpha = 1.f; }
  else { mn = fmaxf(m_reg, pmax); alpha = __builtin_amdgcn_exp2f((m_reg - mn) * C); m_reg = mn; }
  float mnC = -mn * C;
  for (int r = 0; r < 16; ++r) p0[r] = fmaf(p0[r], C, mnC); for (int r = 0; r < 16; ++r) p1[r] = fmaf(p1[r], C, mnC);
  for (int r = 0; r < 16; ++r) p0[r] = __builtin_amdgcn_exp2f(p0[r]);
}
__device__ __forceinline__ void finishSM(f32x16& p0, f32x16& p1, float alpha, float& l_reg, bf16x8& pa0, bf16x8& pa1, bf16x8& pa2, bf16x8& pa3) {
  for (int r = 0; r < 16; ++r) p1[r] = __builtin_amdgcn_exp2f(p1[r]);
  float ps = 0; for (int r = 0; r < 16; ++r) ps += p0[r]; for (int r = 0; r < 16; ++r) ps += p1[r];
  { auto rr = __builtin_amdgcn_permlane32_swap(__float_as_uint(ps), __float_as_uint(ps), false, false);
    ps = __uint_as_float(rr[0]) + __uint_as_float(rr[1]); }
  l_reg = l_reg * alpha + ps;
#define PK4(P, BASE, OUT) do { unsigned a0 = cvtpk(P[BASE + 0], P[BASE + 1]), a1 = cvtpk(P[BASE + 2], P[BASE + 3]);   \
    unsigned b0 = cvtpk(P[BASE + 4], P[BASE + 5]), b1 = cvtpk(P[BASE + 6], P[BASE + 7]);                              \
    auto r0 = __builtin_amdgcn_permlane32_swap(a0, b0, false, false); auto r1 = __builtin_amdgcn_permlane32_swap(a1, b1, false, false); \
    u32x4 w = {r0[0], r1[0], r0[1], r1[1]}; OUT = *reinterpret_cast<bf16x8*>(&w); } while (0)
  PK4(p0, 0, pa0); PK4(p0, 8, pa1); PK4(p1, 0, pa2); PK4(p1, 8, pa3);
#undef PK4
}
__device__ __forceinline__ void qkt(f32x16& p0, f32x16& p1, const bf16* Ks, const bf16x8* qr, int r32, int hi) {
  p0 = f32x16{}; p1 = f32x16{};
  for (int d0 = 0; d0 < 8; ++d0) { int cb = (d0 * 16 + hi * 8) * 2;
    bf16x8 b0 = *reinterpret_cast<const bf16x8*>((const char*)Ks + KSWZ(r32, cb));
    bf16x8 b1 = *reinterpret_cast<const bf16x8*>((const char*)Ks + KSWZ(32 + r32, cb));
    p0 = __builtin_amdgcn_mfma_f32_32x32x16_bf16(b0, qr[d0], p0, 0, 0, 0);
    p1 = __builtin_amdgcn_mfma_f32_32x32x16_bf16(b1, qr[d0], p1, 0, 0, 0); }
}
__device__ __forceinline__ int v_st(int k, int c) { const int kk = (k & ~0xC) | ((k & 4) << 1) | ((k & 8) >> 1); return ((kk >> 3) * 4 + (c >> 5)) * 512 + ((kk & 7) * 32 + (c & 31)) * 2; }
__device__ __forceinline__ int v_rd_base(int lane) { return ((lane & 3) << 3) | (((lane >> 2) & 3) << 6) | (((lane >> 4) & 1) << 5) | (((lane >> 5) & 1) << 8); }
constexpr int v_rd_off(int d0, int ks, int half) { return d0 * 512 + ks * 4096 + half * 2048; }
template <int OFF> __device__ __forceinline__ s16x4 tr_read(int vb) {
  s16x4 r; asm volatile("ds_read_b64_tr_b16 %0, %1 offset:%2" : "=&v"(r) : "v"(vb), "i"(OFF) : "memory"); return r;
}
template <int D0> __device__ __forceinline__ void pv_one(f32x16& od, int vb, bf16x8 pa0, bf16x8 pa1, bf16x8 pa2, bf16x8 pa3) {
  const s16x4 l0 = tr_read<v_rd_off(D0, 0, 0)>(vb), h0 = tr_read<v_rd_off(D0, 0, 1)>(vb), l1 = tr_read<v_rd_off(D0, 1, 0)>(vb), h1 = tr_read<v_rd_off(D0, 1, 1)>(vb);
  const s16x4 l2 = tr_read<v_rd_off(D0, 2, 0)>(vb), h2 = tr_read<v_rd_off(D0, 2, 1)>(vb), l3 = tr_read<v_rd_off(D0, 3, 0)>(vb), h3 = tr_read<v_rd_off(D0, 3, 1)>(vb);
  asm volatile("s_waitcnt lgkmcnt(0)" ::: "memory"); SBAR();
#define PK(L, H) (bf16x8){L[0], L[1], L[2], L[3], H[0], H[1], H[2], H[3]}
  od = __builtin_amdgcn_mfma_f32_32x32x16_bf16(pa0, PK(l0, h0), od, 0, 0, 0);
  od = __builtin_amdgcn_mfma_f32_32x32x16_bf16(pa1, PK(l1, h1), od, 0, 0, 0);
  od = __builtin_amdgcn_mfma_f32_32x32x16_bf16(pa2, PK(l2, h2), od, 0, 0, 0);
  od = __builtin_amdgcn_mfma_f32_32x32x16_bf16(pa3, PK(l3, h3), od, 0, 0, 0);
#undef PK
}
__device__ __forceinline__ void pv_d0(f32x16* o, int vb, bf16x8 pa0, bf16x8 pa1, bf16x8 pa2, bf16x8 pa3) {
  pv_one<0>(o[0], vb, pa0, pa1, pa2, pa3); pv_one<1>(o[1], vb, pa0, pa1, pa2, pa3); pv_one<2>(o[2], vb, pa0, pa1, pa2, pa3); pv_one<3>(o[3], vb, pa0, pa1, pa2, pa3);
}
__device__ __forceinline__ void attn_dense_body(const bf16* __restrict__ Qb, const bf16* __restrict__ Kh, const bf16* __restrict__ Vh,
                                                bf16* __restrict__ Ob, int seq, char* lds) {
  constexpr int SDEPTH = 2;
  const int tid = otid(), wid = tid >> 6, lane = tid & 63, r32 = lane & 31, hi = lane >> 5;
  bf16* V_lds = (bf16*)lds; bf16* K_lds = (bf16*)(lds + 2 * SHM_V);
  float* ws = (float*)(lds + 2 * SHM_V + 2 * SHM_K) + wid * 64; float* li_l = ws; float* al_l = ws + 32;
  float m_reg = -1e30f, l_reg = 0; f32x16 o[4] = {}; bf16x8 qr[8];
  const bf16* Qw = Qb + (long)(wid * QBLK + r32) * LDQ + hi * 8;
#pragma unroll
  for (int d0 = 0; d0 < 8; ++d0) qr[d0] = *reinterpret_cast<const bf16x8*>(Qw + d0 * 16);
  const int sr = tid >> 4, sc = (tid & 15) * 8, vst0 = v_st(sr, sc), vst1 = v_st(32 + sr, sc);
  const int vb0 = (int)(uintptr_t)V_lds + v_rd_base(lane);
  struct { bf16x8 vs0, vs1, ks0, ks1; } sr_[SDEPTH];
#define SLOAD(i, k0) do { sr_[i].vs0 = *reinterpret_cast<const bf16x8*>(&Vh[(long)((k0) + sr) * LDK + sc]); sr_[i].vs1 = *reinterpret_cast<const bf16x8*>(&Vh[(long)((k0) + 32 + sr) * LDK + sc]); \
    sr_[i].ks0 = *reinterpret_cast<const bf16x8*>(&Kh[(long)((k0) + sr) * LDK + sc]); sr_[i].ks1 = *reinterpret_cast<const bf16x8*>(&Kh[(long)((k0) + 32 + sr) * LDK + sc]); } while (0)
#define SWRITE(b, i) do { *(bf16x8*)((char*)V_lds + (b) * SHM_V + vst0) = sr_[i].vs0;          \
    *(bf16x8*)((char*)V_lds + (b) * SHM_V + vst1) = sr_[i].vs1; int kc = sc * 2;               \
    *(bf16x8*)((char*)K_lds + (b) * SHM_K + KSWZ(sr, kc)) = sr_[i].ks0;                       \
    *(bf16x8*)((char*)K_lds + (b) * SHM_K + KSWZ(32 + sr, kc)) = sr_[i].ks1; } while (0)
#define SWAIT() do { asm volatile("s_waitcnt vmcnt(4)" ::: "memory"); } while (0)
#define RESC(a) do { if (__any((a) < 1.f)) { if (hi == 0) al_l[r32] = (a); asm volatile("s_waitcnt lgkmcnt(0)" ::: "memory"); \
    for (int d = 0; d < 4; ++d) for (int r = 0; r < 16; ++r) o[d][r] *= al_l[crow(r, hi)]; } } while (0)
  f32x16 pA0, pA1, pB0, pB1; float mnA, mnB, alA, alB; bf16x8 pa0, pa1, pa2, pa3; const int NT = seq / KVBLK;
  constexpr int SE = 0, SO = SDEPTH - 1;
  SLOAD(SE, 0); asm volatile("s_waitcnt vmcnt(0)" ::: "memory"); SWRITE(0, SE); __syncthreads();
  qkt(pA0, pA1, K_lds, qr, r32, hi); partialSM(pA0, pA1, m_reg, mnA, alA);
  SLOAD(SO, KVBLK); if (2 < NT) SLOAD(SE, 2 * KVBLK);
  SWAIT(); SWRITE(1, SO); __syncthreads();
  for (int j = 1; j + 1 < NT; j += 2) {
    SBAR(); qkt(pB0, pB1, (bf16*)((char*)K_lds + SHM_K), qr, r32, hi);
    finishSM(pA0, pA1, alA, l_reg, pa0, pa1, pa2, pa3); SBAR();
    SLOAD(SO, (j + SDEPTH) * KVBLK); SBAR();
    pv_d0(o, vb0, pa0, pa1, pa2, pa3); partialSM(pB0, pB1, m_reg, mnB, alB);
    __syncthreads(); SWAIT(); SWRITE(0, SE);
    RESC(alB); __syncthreads();
    SBAR(); qkt(pA0, pA1, K_lds, qr, r32, hi);
    finishSM(pB0, pB1, alB, l_reg, pa0, pa1, pa2, pa3); SBAR();
    if (j + 3 < NT) SLOAD(SE, (j + 1 + SDEPTH) * KVBLK); SBAR();
    pv_d0(o, vb0 + (int)SHM_V, pa0, pa1, pa2, pa3); partialSM(pA0, pA1, m_reg, mnA, alA);
    __syncthreads(); SWAIT(); SWRITE(1, SO);
    RESC(alA); __syncthreads();
  }
  SBAR(); qkt(pB0, pB1, (bf16*)((char*)K_lds + SHM_K), qr, r32, hi);
  finishSM(pA0, pA1, alA, l_reg, pa0, pa1, pa2, pa3); SBAR();
  pv_d0(o, vb0, pa0, pa1, pa2, pa3); partialSM(pB0, pB1, m_reg, mnB, alB);
  __syncthreads(); RESC(alB);
  finishSM(pB0, pB1, alB, l_reg, pa0, pa1, pa2, pa3); SBAR();
  pv_d0(o, vb0 + (int)SHM_V, pa0, pa1, pa2, pa3);
  if (hi == 0) li_l[r32] = l_reg; asm volatile("s_waitcnt lgkmcnt(0)" ::: "memory");
  float rli[16];
#pragma unroll
  for (int r = 0; r < 16; ++r) rli[r] = __builtin_amdgcn_rcpf(li_l[crow(r, hi)]);
  bf16* Ow = Ob + (long)(wid * QBLK) * LDO;
#pragma unroll
  for (int r = 0; r < 16; ++r) { int orow = crow(r, hi);
    for (int d0 = 0; d0 < 4; ++d0) Ow[(long)orow * LDO + d0 * 32 + r32] = __float2bfloat16(o[d0][r] * rli[r]); }
#undef SLOAD
#undef SWRITE
#undef SWAIT
#undef RESC
}
#undef KSWZ
#undef SBAR
}
#define LAS __attribute__((address_space(3)))
typedef unsigned short bfu;
typedef short bf16x8 __attribute__((ext_vector_type(8)));
typedef float f32x4 __attribute__((ext_vector_type(4)));
typedef unsigned u32x4v __attribute__((ext_vector_type(4)));
typedef unsigned u32x2v __attribute__((ext_vector_type(2)));
using pg8::DM; using pg8::NBATCH; using pg8::SEQ; using pg8::CTXL; using pg8::RPB; using pg8::MR; using pg8::MH; using pg8::TPB; using pg8::HTILES; using pg8::FFD; using pg8::NMODW;
using pg8::bf2f; using pg8::cvt_pk_bf16; using pg8::fast_silu;
constexpr int NWAVES = 8, NTHR = 512, DEPTH = 4;
constexpr float EPS = 1e-6f;
constexpr int LDS_BYTES = 147456, LDS_CTL_OFF = 131072 + 64;
constexpr size_t al256(size_t x) { return (x + 255) / 256 * 256; }
constexpr size_t WS_BAR = 0, WS_BAR_BYTES = 16384;
constexpr size_t WS_MODS = WS_BAR_BYTES;
constexpr size_t WS_COSR = al256(WS_MODS + (size_t)DEPTH * 9 * NMODW * 4);
constexpr size_t WS_SINR = WS_COSR + (size_t)SEQ * 128 * 4;
constexpr size_t WS_COSRT = WS_SINR + (size_t)SEQ * 128 * 4;
constexpr size_t WS_SINRT = WS_COSRT + (size_t)SEQ * 128 * 4;
constexpr size_t WS_COSA = WS_SINRT + (size_t)SEQ * 128 * 4;
constexpr size_t WS_SINA = WS_COSA + (size_t)SEQ * 64 * 4;
constexpr size_t WS_X = WS_SINA + (size_t)SEQ * 64 * 4;
constexpr size_t WS_XN = WS_X + (size_t)MR * DM * 4;
constexpr size_t WS_W1A = WS_XN + (size_t)MR * DM * 2;
constexpr size_t WS_W2A = WS_W1A + (size_t)2 * FFD * DM * 2;
constexpr size_t WS_W1B = WS_W2A + (size_t)FFD * DM * 2;
constexpr size_t WS_W2B = WS_W1B + (size_t)2 * FFD * DM * 2;
constexpr size_t WS_WMIX = WS_W2B + (size_t)FFD * DM * 2;
constexpr size_t WMIX_QKG = 0, WMIX_KV = (size_t)4096 * DM * 2, WMIX_OUT = WMIX_KV + (size_t)3072 * DM * 2, WMIX_END = WMIX_OUT + (size_t)DM * 2048 * 2;
constexpr size_t WMIX_AQKV = 0, WMIX_AO = (size_t)1536 * DM * 2;
constexpr size_t WS_BIG = WS_WMIX + WMIX_END;
constexpr size_t BIG_QKG = 0, BIG_KVT = (size_t)MH * 4096 * 2, BIG_OF = BIG_KVT + (size_t)3072 * MH * 2, BIG_OB = BIG_OF + (size_t)MH * 2048 * 2, BIG_SP = BIG_OB + (size_t)MH * 2048 * 2,
                 BIG_RET_END = BIG_SP + (size_t)544 * 128 * 128 * 2;
constexpr size_t BIG_AQKV = 0, BIG_AO = (size_t)MR * 1536 * 2;
constexpr size_t BIG_H_END = (size_t)MR * FFD * 2;
constexpr size_t BIG_PART = (size_t)200 * 1048576, PART_KS = 11;
static_assert(BIG_PART >= BIG_H_END && BIG_PART + PART_KS * (size_t)NBATCH * CTXL * DM * 4 <= BIG_RET_END, "partial slabs inside BIG");
constexpr size_t WS_END = WS_BIG + (BIG_RET_END > BIG_H_END ? BIG_RET_END : BIG_H_END);

struct Args {
    const float *x, *c, *ctx, *c_ctx, *ada_w, *ada_b, *norm_g, *ffn_w1, *ffn_w2, *ret_w_in, *ret_w_out, *ret_dec_f, *ret_dec_b, *att_w_qkv, *att_w_o, *att_qg, *att_kg, *final_g;
    float* out; unsigned char* ws;
};

__device__ __forceinline__ float wave_sum(float v) {
#pragma unroll
    for (int o = 1; o < 64; o <<= 1) v += __shfl_xor(v, o);
    return v;
}
__device__ __forceinline__ unsigned f2bf(float f) { unsigned u = __builtin_bit_cast(unsigned, f); return (u + 0x7fffu + ((u >> 16) & 1u)) >> 16; }
__device__ __forceinline__ unsigned pk2(float lo, float hi) { return f2bf(lo) | (f2bf(hi) << 16); }
#define XB_TMO      128
#define XB_XCNT(j)  (256  + 64 * (j))
#define XB_XSUB(j)  (1280 + 64 * (j))
#define XB_XGEN(j)  (2304 + 64 * (j))
#define XB_TOP      3328
#define XB_TOPGEN   3392
#define XCD_BAR_WORDS 3456
#define XB_SPIN_CAP (1u << 18)

__device__ __forceinline__ unsigned xb_ld(unsigned* p)              { return __hip_atomic_load(p, __ATOMIC_RELAXED, __HIP_MEMORY_SCOPE_AGENT); }
__device__ __forceinline__ unsigned xb_add(unsigned* p, unsigned v) { return __hip_atomic_fetch_add(p, v, __ATOMIC_RELAXED, __HIP_MEMORY_SCOPE_AGENT); }
__device__ __forceinline__ unsigned xb_xcc_id() { return (unsigned)__builtin_amdgcn_s_getreg((3 << 11) | 20) & 0xFu; }
#define XB_SPIN(cond, bar) do { unsigned _sp = 0; while (cond) { __builtin_amdgcn_s_sleep(1); \
    if ((++_sp & 255u) == 0u) { if (xb_ld(&(bar)[XB_TMO])) break; if (_sp > XB_SPIN_CAP) { atomicAdd(&(bar)[XB_TMO], 1u); break; } } } } while (0)

struct XcdBarrier {
    unsigned* bar; unsigned x;
    volatile LAS unsigned* st;
};

__device__ __forceinline__ XcdBarrier xcd_barrier_post(unsigned* bar, volatile LAS unsigned* st) {
    XcdBarrier b; b.bar = bar; b.x = xb_xcc_id(); b.st = st;
    if (otid() == 0) (void)xb_add(&bar[XB_XCNT(b.x)], 1u);
    return b;
}
__device__ __forceinline__ void xcd_barrier_complete(unsigned* bar, unsigned x, unsigned& nloc, unsigned& nx) {
    const unsigned G = (unsigned)ogrid();
    unsigned sum, cnt, mine, sp = 0u;
    for (;;) {
        sum = 0u; cnt = 0u; mine = 0u;
#pragma unroll
        for (unsigned j = 0; j < 16; ++j) { const unsigned c = xb_ld(&bar[XB_XCNT(j)]); sum += c; cnt += (c > 0u) ? 1u : 0u; mine = (j == x) ? c : mine; }
        if (sum == G) break;
        __builtin_amdgcn_s_sleep(1);
        if ((++sp & 255u) == 0u) { if (xb_ld(&bar[XB_TMO])) break; if (sp > XB_SPIN_CAP) { atomicAdd(&bar[XB_TMO], 1u); break; } }
    }
    nloc = mine > 0u ? mine : 1u; nx = cnt > 0u ? cnt : 1u;
}

__device__ __forceinline__ void xcd_barrier(const XcdBarrier& b) {
    asm volatile("s_waitcnt vmcnt(0)" ::: "memory");
    __syncthreads();
    if (otid() == 0) {
        unsigned* bar = b.bar;
        __builtin_amdgcn_s_waitcnt(0);
        unsigned nloc = b.st[0], nx = b.st[1];
        if (nloc == 0u) { xcd_barrier_complete(bar, b.x, nloc, nx); b.st[0] = nloc; b.st[1] = nx; }
        const unsigned old = xb_add(&bar[XB_XSUB(b.x)], 1u);
        const unsigned gen = old / nloc;
        if (old + 1u == (gen + 1u) * nloc) {
            __builtin_amdgcn_fence(__ATOMIC_RELEASE, "agent");
            asm volatile("s_waitcnt vmcnt(0)" ::: "memory");
            const unsigned og = xb_add(&bar[XB_TOP], 1u);
            const unsigned tg = og / nx;
            if (og + 1u == (tg + 1u) * nx) xb_add(&bar[XB_TOPGEN], 1u);
            else XB_SPIN(xb_ld(&bar[XB_TOPGEN]) == tg, bar);
            __builtin_amdgcn_fence(__ATOMIC_ACQUIRE, "agent");
            xb_add(&bar[XB_XGEN(b.x)], 1u);
            asm volatile("s_waitcnt vmcnt(0)" ::: "memory");
        } else {
            XB_SPIN(xb_ld(&bar[XB_XGEN(b.x)]) == gen, bar);
            __builtin_amdgcn_fence(__ATOMIC_ACQUIRE, "agent");
            asm volatile("s_waitcnt vmcnt(0)" ::: "memory");
        }
    }
    __syncthreads();
}


__device__ __forceinline__ void transpose_item(const float* W, int K, int N, bfu* WT, int k0, int n0, int drow, float scale, LAS float* scr, int lane) {
#pragma unroll 8
    for (int i = 0; i < 32; ++i) { const int kk = 2 * i + (lane >> 5); scr[kk * 33 + (lane & 31)] = W[(size_t)(k0 + kk) * N + n0 + (lane & 31)] * scale; }
    asm volatile("s_waitcnt lgkmcnt(0)" ::: "memory");
    const int c = lane & 7;
#pragma unroll
    for (int j = 0; j < 4; ++j) { const int n = (lane >> 3) + 8 * j; const LAS float* s = scr + (8 * c) * 33 + n;
        u32x4v o; o.x = pk2(s[0 * 33], s[1 * 33]); o.y = pk2(s[2 * 33], s[3 * 33]); o.z = pk2(s[4 * 33], s[5 * 33]); o.w = pk2(s[6 * 33], s[7 * 33]);
        *(u32x4v*)(WT + (size_t)(drow + n) * K + k0 + 8 * c) = o; }
    asm volatile("s_waitcnt lgkmcnt(0)" ::: "memory");
}
__device__ __forceinline__ void conv_job(const float* W, int K, int N, int c0, int cnt, bfu* WT, int drow0, float scale, int mode, LAS float* scr, int lane, int gw, int NGW) {
    const int nblk = cnt / 32, nitems = (K / 64) * nblk;
    for (int it = gw; it < nitems; it += NGW) {
        const int kb = it / nblk, nb = it - kb * nblk; const int col = c0 + 32 * nb; int drow;
        if (mode == 0) drow = drow0 + 32 * nb;
        else { const int up = col >= FFD, j = up ? col - FFD : col; drow = 256 * (j >> 7) + (up ? 128 : 0) + (j & 127); }
        transpose_item(W, K, N, WT, 64 * kb, col, drow, scale, scr, lane);
    }
}
#define MFMA16(a, b, c) __builtin_amdgcn_mfma_f32_16x16x32_bf16((a), (b), (c), 0, 0, 0)

__device__ __forceinline__ void phase_ada_rope(const Args& a, unsigned char* ws, LAS unsigned char* lds) {
    const int tid = otid(), lane = tid & 63, wave = tid >> 6;
    LAS float* scs = (LAS float*)lds;
    LAS float* part = (LAS float*)(lds + 9 * 1024 * 4);
    for (int i = tid; i < 9 * 1024; i += NTHR) { const float v = (i < 8 * 1024) ? a.c[i] : a.c_ctx[i - 8 * 1024]; scs[i] = v / (1.0f + expf(-v)); }
    __syncthreads();
    float* mods = (float*)(ws + WS_MODS);
    for (int it = obid(); it < DEPTH * 144; it += ogrid()) {
        const int l = it / 144, cg0 = (it - l * 144) * 64, col = cg0 + lane;
        const float* wp = a.ada_w + ((size_t)l * DM + wave * 128) * NMODW + col;
        float acc[9];
#pragma unroll
        for (int r = 0; r < 9; ++r) acc[r] = 0.f;
        for (int k = 0; k < 128; k += 16) {
            float wv[16];
#pragma unroll
            for (int i = 0; i < 16; ++i) wv[i] = wp[(size_t)(k + i) * NMODW];
#pragma unroll
            for (int q = 0; q < 4; ++q)
#pragma unroll
                for (int r = 0; r < 9; ++r) { const f32x4 s = *(const LAS f32x4*)(scs + r * 1024 + wave * 128 + k + 4 * q); acc[r] += s[0] * wv[4 * q] + s[1] * wv[4 * q + 1] + s[2] * wv[4 * q + 2] + s[3] * wv[4 * q + 3]; }
        }
#pragma unroll
        for (int r = 0; r < 9; ++r) part[(wave * 9 + r) * 64 + lane] = acc[r];
        __syncthreads();
        for (int o = tid; o < 9 * 64; o += NTHR) { const int r = o >> 6, cc = o & 63; float s = 0.f;
#pragma unroll
            for (int w = 0; w < 8; ++w) s += part[(w * 9 + r) * 64 + cc];
            mods[((size_t)l * 9 + r) * NMODW + cg0 + cc] = s + a.ada_b[(size_t)l * NMODW + cg0 + cc]; }
        __syncthreads();
    }
    float* cosR = (float*)(ws + WS_COSR); float* sinR = (float*)(ws + WS_SINR); float* cosRT = (float*)(ws + WS_COSRT); float* sinRT = (float*)(ws + WS_SINRT);
    float* cosA = (float*)(ws + WS_COSA); float* sinA = (float*)(ws + WS_SINA);
    const int gt = obid() * NTHR + tid, NT = ogrid() * NTHR;
    const double TWO_PI = 6.283185307179586476925286766559, L2T = 13.287712379549449391481277717958;
    for (int i = gt; i < SEQ * 128; i += NT) { const int pos = i >> 7, j = i & 127;
        const double fr = exp2(-(double)j * (1.0 / 128.0) * L2T); double ang = (double)pos * fr; ang -= TWO_PI * rint(ang / TWO_PI);
        const float cs = cosf((float)ang), sn = sinf((float)ang);
        cosR[i] = cs; sinR[i] = sn; cosRT[(size_t)j * SEQ + pos] = cs; sinRT[(size_t)j * SEQ + pos] = sn; }
    for (int i = gt; i < SEQ * 64; i += NT) { const int pos = i >> 6, jj = i & 63;
        const double fr = exp2(-(double)(jj & 31) * (1.0 / 32.0) * L2T); const int pv = (jj < 32) ? (pos >> 6) : (pos & 63);
        double ang = (double)pv * fr; ang -= TWO_PI * rint(ang / TWO_PI);
        cosA[i] = cosf((float)ang); sinA[i] = sinf((float)ang); }
}

__device__ __forceinline__ void phase_conv_weights(const Args& a, unsigned char* ws, LAS unsigned char* lds, int L) {
    const int tid = otid(), lane = tid & 63, wave = tid >> 6; const int gw = obid() * NWAVES + wave, NGW = ogrid() * NWAVES;
    LAS float* scr = (LAS float*)(lds + wave * 16384);
    const float* w1 = a.ffn_w1 + (size_t)L * 2 * DM * 2 * FFD; const float* w2 = a.ffn_w2 + (size_t)L * 2 * FFD * DM;
    conv_job(w1, DM, 2 * FFD, 0, 2 * FFD, (bfu*)(ws + WS_W1A), 0, 1.f, 1, scr, lane, gw, NGW);
    conv_job(w1 + (size_t)DM * 2 * FFD, DM, 2 * FFD, 0, 2 * FFD, (bfu*)(ws + WS_W1B), 0, 1.f, 1, scr, lane, gw, NGW);
    conv_job(w2, FFD, DM, 0, DM, (bfu*)(ws + WS_W2A), 0, 1.f, 0, scr, lane, gw, NGW);
    conv_job(w2 + (size_t)FFD * DM, FFD, DM, 0, DM, (bfu*)(ws + WS_W2B), 0, 1.f, 0, scr, lane, gw, NGW);
    const int j = L >> 1;
    if ((L & 1) == 0) {
        const float* win = a.ret_w_in + (size_t)j * DM * 6144; const float* wout = a.ret_w_out + (size_t)j * 2048 * DM;
        bfu* qkg = (bfu*)(ws + WS_WMIX + WMIX_QKG); bfu* kv = (bfu*)(ws + WS_WMIX + WMIX_KV);
        conv_job(win, DM, 6144, 0, 1024, qkg, 0, 1.f, 0, scr, lane, gw, NGW);
        conv_job(win, DM, 6144, 1024, 1024, qkg, 1024, 0.0625f, 0, scr, lane, gw, NGW);
        conv_job(win, DM, 6144, 4096, 2048, qkg, 2048, 1.f, 0, scr, lane, gw, NGW);
        conv_job(win, DM, 6144, 1024, 1024, kv, 0, 0.0625f, 0, scr, lane, gw, NGW);
        conv_job(win, DM, 6144, 2048, 2048, kv, 1024, 1.f, 0, scr, lane, gw, NGW);
        conv_job(wout, 2048, DM, 0, DM, (bfu*)(ws + WS_WMIX + WMIX_OUT), 0, 1.f, 0, scr, lane, gw, NGW);
    } else {
        conv_job(a.att_w_qkv + (size_t)j * DM * 1536, DM, 1536, 0, 1536, (bfu*)(ws + WS_WMIX + WMIX_AQKV), 0, 1.f, 0, scr, lane, gw, NGW);
        conv_job(a.att_w_o + (size_t)j * DM * DM, DM, DM, 0, DM, (bfu*)(ws + WS_WMIX + WMIX_AO), 0, 1.f, 0, scr, lane, gw, NGW);
    }
}

__device__ __forceinline__ void phase_modnorm(const Args& a, unsigned char* ws, int L, int idx, bool first, int pend) {
    const int tid = otid(), lane = tid & 63, wave = tid >> 6; const int gw = obid() * NWAVES + wave, NGW = ogrid() * NWAVES;
    const float* mods = (const float*)(ws + WS_MODS) + (size_t)L * 9 * NMODW; const float* ng = a.norm_g + (size_t)(L * 3 + idx) * DM;
    float* X = (float*)(ws + WS_X); bfu* XN = (bfu*)(ws + WS_XN);
    for (int r = gw; r < MR; r += NGW) {
        const int b = r / RPB, t = r - b * RPB; const int mrow = (t >= SEQ) ? 8 : b;
        const float* src = first ? ((t < SEQ) ? a.x + ((size_t)b * SEQ + t) * DM : a.ctx + ((size_t)b * CTXL + (t - SEQ)) * DM) : X + (size_t)r * DM;
        f32x4 v[4]; float s = 0.f;
#pragma unroll
        for (int j = 0; j < 4; ++j) { v[j] = ((const f32x4*)src)[lane + 64 * j]; s += (v[j][0] * v[j][0] + v[j][1] * v[j][1]) + (v[j][2] * v[j][2] + v[j][3] * v[j][3]); }
        if (pend && t >= SEQ) {
            const float* gt = (const float*)(ws + WS_MODS) + (size_t)(pend == 1 ? L : L - 1) * 9 * NMODW + (size_t)8 * NMODW + (pend == 1 ? 2 : 8) * DM;
            const float* P = (const float*)(ws + WS_BIG + BIG_PART) + (size_t)(b * CTXL + (t - SEQ)) * DM; s = 0.f;
#pragma unroll
            for (int j = 0; j < 4; ++j) { f32x4 acc = (f32x4){0.f, 0.f, 0.f, 0.f};
#pragma unroll
                for (int ks = 0; ks < (int)PART_KS; ++ks) acc = acc + ((const f32x4*)(P + (size_t)ks * NBATCH * CTXL * DM))[lane + 64 * j];
                const f32x4 g4 = *(const f32x4*)(gt + 4 * lane + 256 * j);
                v[j] = v[j] + (g4 * 0.5f) * acc; s += (v[j][0] * v[j][0] + v[j][1] * v[j][1]) + (v[j][2] * v[j][2] + v[j][3] * v[j][3]); }
        }
        if (first || (pend && t >= SEQ)) {
#pragma unroll
            for (int j = 0; j < 4; ++j) ((f32x4*)(X + (size_t)r * DM))[lane + 64 * j] = v[j];
        }
        const float rstd = rsqrtf(wave_sum(s) * (1.0f / DM) + EPS);
        const float* sh = mods + (size_t)mrow * NMODW + (3 * idx) * DM; const float* sc = sh + DM;
#pragma unroll
        for (int j = 0; j < 4; ++j) { const int col = 4 * lane + 256 * j;
            const f32x4 g4 = *(const f32x4*)(ng + col), s4 = *(const f32x4*)(sc + col), h4 = *(const f32x4*)(sh + col);
            const f32x4 y = (v[j] * rstd) * g4 * (s4 + 1.0f) + h4;
            u32x2v w; w.x = pk2(y[0], y[1]); w.y = pk2(y[2], y[3]); *(u32x2v*)(XN + (size_t)r * DM + col) = w; }
    }
}
__device__ __forceinline__ void phase_final(const Args& a, unsigned char* ws) {
    const int tid = otid(), lane = tid & 63, wave = tid >> 6; const int gw = obid() * NWAVES + wave, NGW = ogrid() * NWAVES;
    const float* X = (const float*)(ws + WS_X);
    for (int q = gw; q < NBATCH * SEQ; q += NGW) {
        const int b = q / SEQ, t = q - b * SEQ; const float* src = X + ((size_t)b * RPB + t) * DM;
        f32x4 v[4]; float s = 0.f;
#pragma unroll
        for (int j = 0; j < 4; ++j) { v[j] = ((const f32x4*)src)[lane + 64 * j]; s += (v[j][0] * v[j][0] + v[j][1] * v[j][1]) + (v[j][2] * v[j][2] + v[j][3] * v[j][3]); }
        const float rstd = rsqrtf(wave_sum(s) * (1.0f / DM) + EPS);
#pragma unroll
        for (int j = 0; j < 4; ++j) { const int col = 4 * lane + 256 * j; const f32x4 g4 = *(const f32x4*)(a.final_g + col);
            *(f32x4*)(a.out + (size_t)q * DM + col) = (v[j] * rstd) * g4; }
    }
}

__device__ __forceinline__ void phase_qknorm(const Args& a, unsigned char* ws, int j) {
    const int tid = otid(), lane = tid & 63, wave = tid >> 6; const int gw = obid() * NWAVES + wave, NGW = ogrid() * NWAVES;
    bfu* QKV = (bfu*)(ws + WS_BIG + BIG_AQKV); const float* cosA = (const float*)(ws + WS_COSA); const float* sinA = (const float*)(ws + WS_SINA);
    const int sub = lane & 15;
    for (int it = gw * 4 + (lane >> 4); it < MR * 10; it += NGW * 4) {
        const int r = it / 10, hh = it - r * 10; const int b = r / RPB, t = r - b * RPB;
        bfu* p = QKV + (size_t)r * 1536 + hh * 128 + 8 * sub;
        const bf16x8 raw = *(const bf16x8*)p; float x[8]; float ss = 0.f;
#pragma unroll
        for (int i = 0; i < 8; ++i) { x[i] = bf2f((unsigned short)raw[i]); ss += x[i] * x[i]; }
        ss += __shfl_xor(ss, 1); ss += __shfl_xor(ss, 2); ss += __shfl_xor(ss, 4); ss += __shfl_xor(ss, 8);
        const float rstd = rsqrtf(ss * (1.0f / 128.0f) + EPS);
        const float* gn = ((hh < 8) ? a.att_qg : a.att_kg) + (size_t)j * 128 + 8 * sub;
#pragma unroll
        for (int i = 0; i < 8; ++i) x[i] = x[i] * rstd * gn[i];
        const bool lat = t < SEQ; const int jj = 8 * (sub & 7); const int tt = lat ? t : 0;
#pragma unroll
        for (int i = 0; i < 8; ++i) { const float other = __shfl_xor(x[i], 8); const float cs = cosA[(size_t)tt * 64 + jj + i], sn = sinA[(size_t)tt * 64 + jj + i];
            const float rot = (sub < 8) ? (x[i] * cs - other * sn) : (x[i] * cs + other * sn); x[i] = lat ? rot : x[i]; }
        u32x4v w; w.x = pk2(x[0], x[1]); w.y = pk2(x[2], x[3]); w.z = pk2(x[4], x[5]); w.w = pk2(x[6], x[7]);
        *(u32x4v*)p = w;
    }
}
__device__ __forceinline__ void phase_attention(unsigned char* ws, char* lds) {
    const attn::bf16* QKV = (const attn::bf16*)(ws + WS_BIG + BIG_AQKV); attn::bf16* AO = (attn::bf16*)(ws + WS_BIG + BIG_AO);
    for (int u = obid(); u < 1024 + 64; u += ogrid()) {
        int b, h, row0, key0, seq;
        if (u < 1024) { const int qb = u & 15; h = (u >> 4) & 7; b = u >> 7; row0 = b * RPB + qb * 256; key0 = b * RPB; seq = RPB; }
        else { const int v = u - 1024; h = v & 7; b = v >> 3; row0 = b * RPB + SEQ; key0 = b * RPB + SEQ; seq = CTXL; }
        const int kvh = h >> 2;
        attn::attn_dense_body(QKV + (size_t)row0 * 1536 + h * 128, QKV + (size_t)key0 * 1536 + 1024 + kvh * 128, QKV + (size_t)key0 * 1536 + 1280 + kvh * 128,
                              AO + (size_t)row0 * 1024 + h * 128, seq, lds);
        __syncthreads();
    }
}

__device__ __forceinline__ int ret_tok0(int bl, int cidx) { return bl * RPB + ((cidx < 32) ? 128 * cidx : SEQ + 128 * (cidx - 32)); }
__device__ __forceinline__ void phase_ret_sprime(const Args& a, unsigned char* ws, int j) {
    const int tid = otid(), lane = tid & 63, w = tid >> 6, r16 = lane & 15, quad = lane >> 4;
    const bfu* QKG = (const bfu*)(ws + WS_BIG + BIG_QKG); bfu* SP = (bfu*)(ws + WS_BIG + BIG_SP);
    for (int it = obid(); it < 544; it += ogrid()) {
        const int bh = it / 34, cidx = it - bh * 34, bl = bh >> 2, h = bh & 3; const int tok0 = ret_tok0(bl, cidx);
        const float l2f = -expf(a.ret_dec_f[j * 4 + h]) * 1.4426950408889634f, l2b = -expf(a.ret_dec_b[j * 4 + h]) * 1.4426950408889634f;
        const bfu* qp = QKG + (size_t)(tok0 + 16 * w + r16) * 4096 + 256 * h + 8 * quad;
        const bfu* kp = QKG + (size_t)(tok0 + r16) * 4096 + 1024 + 256 * h + 8 * quad;
        f32x4 acc[8];
#pragma unroll
        for (int mb = 0; mb < 8; ++mb) acc[mb] = (f32x4){0.f, 0.f, 0.f, 0.f};
#pragma unroll 2
        for (int ks = 0; ks < 8; ++ks) {
            const bf16x8 bq = *(const bf16x8*)(qp + 32 * ks);
#pragma unroll
            for (int mb = 0; mb < 8; ++mb) { const bf16x8 ak = *(const bf16x8*)(kp + (size_t)(16 * mb) * 4096 + 32 * ks); acc[mb] = MFMA16(ak, bq, acc[mb]); }
        }
        const int c = 16 * w + r16;
#pragma unroll
        for (int mb = 0; mb < 8; ++mb) { float v[4];
#pragma unroll
            for (int jj = 0; jj < 4; ++jj) { const int m = 16 * mb + 4 * quad + jj; const int d = c - m;
                const float mk = (d > 0) ? __builtin_amdgcn_exp2f((float)d * l2f) : ((d < 0) ? __builtin_amdgcn_exp2f((float)(-d) * l2b) : 2.0f); v[jj] = acc[mb][jj] * mk; }
            u32x2v o; o.x = cvt_pk_bf16(v[0], v[1]); o.y = cvt_pk_bf16(v[2], v[3]);
            *(u32x2v*)(SP + ((size_t)it * 128 + c) * 128 + 16 * mb + 4 * quad) = o; }
    }
}
constexpr int SROW = 264, KROW = 264, VROW = 136;
__device__ __forceinline__ int scan_cidx(int s, int dir) { return (s < 2) ? (dir ? (33 - s) : (32 + s)) : (dir ? (33 - s) : (s - 2)); }
__device__ __forceinline__ void phase_ret_scan(const Args& a, unsigned char* ws, LAS unsigned char* lds, int j) {
    const int tid = otid(), lane = tid & 63, w = tid >> 6, r16 = lane & 15, quad = lane >> 4;
    const bfu* QKG = (const bfu*)(ws + WS_BIG + BIG_QKG); const bfu* KVT = (const bfu*)(ws + WS_BIG + BIG_KVT);
    LAS bfu* SL = (LAS bfu*)lds; LAS bfu* KB = SL + 64 * SROW; LAS bfu* VB = KB + 64 * KROW;
    for (int it = obid(); it < 256; it += ogrid()) {
        const int es = it & 7, dir = (it >> 3) & 1, h = (it >> 4) & 3, bl = it >> 6;
        bfu* OD = (bfu*)(ws + WS_BIG + (dir ? BIG_OB : BIG_OF));
        const float l2f = -expf(a.ret_dec_f[j * 4 + h]) * 1.4426950408889634f, l2b = -expf(a.ret_dec_b[j * 4 + h]) * 1.4426950408889634f;
        const float l2g = dir ? l2b : l2f;
        const float gC = __builtin_amdgcn_exp2f(128.0f * l2g);
        const int cl = 16 * w + r16;
        const float xi = __builtin_amdgcn_exp2f((dir ? (float)(128 - cl) : (float)(cl + 1)) * l2g);
        float rp[8];
#pragma unroll
        for (int i = 0; i < 8; ++i) rp[i] = __builtin_amdgcn_exp2f((dir ? (float)i : (float)(-i)) * l2g);
        f32x4 st[4][2];
#pragma unroll
        for (int eb = 0; eb < 4; ++eb) { st[eb][0] = (f32x4){0.f, 0.f, 0.f, 0.f}; st[eb][1] = (f32x4){0.f, 0.f, 0.f, 0.f}; }
        for (int i = tid; i < 64 * SROW; i += NTHR) SL[i] = 0;
        const bfu* gkb = QKG + (size_t)(64 * dir + (tid >> 5)) * 4096 + 1024 + 256 * h + (tid & 31) * 8;
        const bfu* gvb = KVT + (size_t)(1024 + 512 * h + 64 * es + (tid >> 4)) * MH + (tid & 15) * 8;
        LAS bfu* kst = KB + (tid >> 5) * KROW + (tid & 31) * 8;  LAS bfu* vst = VB + (tid >> 4) * VROW + (tid & 15) * 8;
        const bfu* qb_ = QKG + (size_t)cl * 4096 + 256 * h + 8 * quad;
        const bfu* kTb = KVT + (size_t)(256 * h + 32 * w + r16) * MH + 8 * quad;
        bf16x8 bq[8], kr[4][2], gk[4], gv[2];
        {   const int tok = ret_tok0(bl, scan_cidx(0, dir));
#pragma unroll
            for (int p = 0; p < 4; ++p) gk[p] = *(const bf16x8*)(gkb + (size_t)(tok + 16 * p) * 4096);
#pragma unroll
            for (int p = 0; p < 2; ++p) gv[p] = *(const bf16x8*)(gvb + (size_t)(32 * p) * MH + tok);
#pragma unroll
            for (int ks = 0; ks < 8; ++ks) bq[ks] = *(const bf16x8*)(qb_ + (size_t)tok * 4096 + 32 * ks);
#pragma unroll
            for (int p = 0; p < 4; ++p) *(LAS bf16x8*)(kst + 16 * p * KROW) = gk[p];
#pragma unroll
            for (int p = 0; p < 2; ++p) *(LAS bf16x8*)(vst + 32 * p * VROW) = gv[p];
        }
        __syncthreads();
#pragma unroll 1
        for (int s = 0; s < 34; ++s) {
            const int tok0 = ret_tok0(bl, scan_cidx(s, dir)); const int tokn = ret_tok0(bl, scan_cidx(s < 33 ? s + 1 : s, dir));
#pragma unroll
            for (int ks = 0; ks < 4; ++ks) { kr[ks][0] = *(const bf16x8*)(kTb + tok0 + 32 * ks); kr[ks][1] = *(const bf16x8*)(kTb + (size_t)16 * MH + tok0 + 32 * ks); }
            f32x4 oa[4], sa[4];
#pragma unroll
            for (int eb = 0; eb < 4; ++eb) { oa[eb] = (f32x4){0.f, 0.f, 0.f, 0.f}; sa[eb] = (f32x4){0.f, 0.f, 0.f, 0.f}; }
            const LAS bfu* sl = SL + r16 * SROW + 8 * quad; const LAS bfu* kl = KB + r16 * KROW + 8 * quad; const LAS bfu* vl = VB + r16 * VROW;
#pragma unroll
            for (int ks = 0; ks < 8; ++ks) { bf16x8 fa[4], fk[4];
#pragma unroll
                for (int eb = 0; eb < 4; ++eb) { fa[eb] = *(const LAS bf16x8*)(sl + 16 * eb * SROW + 32 * ks); fk[eb] = *(const LAS bf16x8*)(kl + 16 * eb * KROW + 32 * ks); }
#pragma unroll
                for (int eb = 0; eb < 4; ++eb) { oa[eb] = MFMA16(fa[eb], bq[ks], oa[eb]); sa[eb] = MFMA16(fk[eb], bq[ks], sa[eb]); } }
#pragma unroll
            for (int ks = 0; ks < 8; ++ks) bq[ks] = *(const bf16x8*)(qb_ + (size_t)tokn * 4096 + 32 * ks);
#pragma unroll
            for (int p = 0; p < 4; ++p) gk[p] = *(const bf16x8*)(gkb + (size_t)(tokn + 16 * p) * 4096);
#pragma unroll
            for (int p = 0; p < 2; ++p) gv[p] = *(const bf16x8*)(gvb + (size_t)(32 * p) * MH + tokn);
#pragma unroll
            for (int eb = 0; eb < 4; ++eb) oa[eb] = oa[eb] * xi;
            unsigned sw2[4][2];
#pragma unroll
            for (int mb2 = 0; mb2 < 4; ++mb2) { float v[4];
#pragma unroll
                for (int jj = 0; jj < 4; ++jj) { const int m = 64 * dir + 16 * mb2 + 4 * quad + jj; const int d = cl - m;
                    const float mk = (d > 0) ? __builtin_amdgcn_exp2f((float)d * l2f) : ((d < 0) ? __builtin_amdgcn_exp2f((float)(-d) * l2b) : 2.0f); v[jj] = sa[mb2][jj] * mk; }
                sw2[mb2][0] = cvt_pk_bf16(v[0], v[1]); sw2[mb2][1] = cvt_pk_bf16(v[2], v[3]); }
#pragma unroll
            for (int kk = 0; kk < 2; ++kk) { u32x4v bw; bw.x = sw2[2 * kk][0]; bw.y = sw2[2 * kk][1]; bw.z = sw2[2 * kk + 1][0]; bw.w = sw2[2 * kk + 1][1];
                const bf16x8 bs = __builtin_bit_cast(bf16x8, bw);
#pragma unroll
                for (int eb = 0; eb < 4; ++eb) { const LAS bfu* vp = vl + 16 * eb * VROW + 64 * dir + 32 * kk + 4 * quad;
                    const u32x2v a0 = *(const LAS u32x2v*)vp, a1 = *(const LAS u32x2v*)(vp + 16);
                    u32x4v aw; aw.x = a0.x; aw.y = a0.y; aw.z = a1.x; aw.w = a1.y; oa[eb] = MFMA16(__builtin_bit_cast(bf16x8, aw), bs, oa[eb]); } }
            asm volatile("s_nop 15\n\ts_nop 7" : "+v"(oa[0]), "+v"(oa[1]), "+v"(oa[2]), "+v"(oa[3]));
            bfu* op = OD + (size_t)(tok0 + cl) * 2048 + 512 * h + 64 * es + 4 * quad;
#pragma unroll
            for (int eb = 0; eb < 4; ++eb) { u32x2v o; o.x = cvt_pk_bf16(oa[eb][0], oa[eb][1]); o.y = cvt_pk_bf16(oa[eb][2], oa[eb][3]); *(u32x2v*)(op + 16 * eb) = o; }
#pragma unroll
            for (int eb = 0; eb < 4; ++eb) { st[eb][0] = st[eb][0] * gC; st[eb][1] = st[eb][1] * gC; }
#pragma unroll
            for (int ks = 0; ks < 4; ++ks) { const int c0 = 32 * ks + 8 * quad;
                const float zb = __builtin_amdgcn_exp2f((dir ? (float)c0 : (float)(127 - c0)) * l2g);
                bf16x8 kz[2];
#pragma unroll
                for (int db = 0; db < 2; ++db) { float z[8];
#pragma unroll
                    for (int i = 0; i < 8; ++i) z[i] = bf2f((unsigned short)kr[ks][db][i]) * (zb * rp[i]);
                    u32x4v kw; kw.x = cvt_pk_bf16(z[0], z[1]); kw.y = cvt_pk_bf16(z[2], z[3]); kw.z = cvt_pk_bf16(z[4], z[5]); kw.w = cvt_pk_bf16(z[6], z[7]);
                    kz[db] = __builtin_bit_cast(bf16x8, kw); }
#pragma unroll
                for (int eb = 0; eb < 4; ++eb) { const bf16x8 vfr = *(const LAS bf16x8*)(vl + 16 * eb * VROW + 32 * ks + 8 * quad);
                    st[eb][0] = MFMA16(vfr, kz[0], st[eb][0]); st[eb][1] = MFMA16(vfr, kz[1], st[eb][1]); } }
            asm volatile("s_waitcnt lgkmcnt(0)" ::: "memory"); __builtin_amdgcn_s_barrier(); asm volatile("" ::: "memory");
#pragma unroll
            for (int eb = 0; eb < 4; ++eb)
#pragma unroll
                for (int db = 0; db < 2; ++db)
#pragma unroll
                    for (int jj = 0; jj < 4; ++jj) SL[(16 * eb + 4 * quad + jj) * SROW + 32 * w + 16 * db + r16] = (bfu)f2bf(st[eb][db][jj]);
#pragma unroll
            for (int p = 0; p < 4; ++p) *(LAS bf16x8*)(kst + 16 * p * KROW) = gk[p];
#pragma unroll
            for (int p = 0; p < 2; ++p) *(LAS bf16x8*)(vst + 32 * p * VROW) = gv[p];
            asm volatile("s_waitcnt lgkmcnt(0)" ::: "memory"); __builtin_amdgcn_s_barrier(); asm volatile("" ::: "memory");
        }
        __syncthreads();
    }
}
__device__ __forceinline__ void phase_ret_merge(unsigned char* ws) {
    const int tid = otid(), lane = tid & 63, wave = tid >> 6; const int gw = obid() * NWAVES + wave, NGW = ogrid() * NWAVES;
    bfu* OF = (bfu*)(ws + WS_BIG + BIG_OF); const bfu* OB = (const bfu*)(ws + WS_BIG + BIG_OB); const bfu* QKG = (const bfu*)(ws + WS_BIG + BIG_QKG);
    for (int it = gw; it < MH * 4; it += NGW) {
        const int r = it >> 2, h = it & 3; const size_t off = (size_t)r * 2048 + 512 * h + 8 * lane;
        const bf16x8 f = *(const bf16x8*)(OF + off), b = *(const bf16x8*)(OB + off), g = *(const bf16x8*)(QKG + (size_t)r * 4096 + 2048 + 512 * h + 8 * lane);
        float o[8]; float ss = 0.f;
#pragma unroll
        for (int i = 0; i < 8; ++i) { o[i] = bf2f((unsigned short)f[i]) + bf2f((unsigned short)b[i]); ss += o[i] * o[i]; }
        const float rstd = rsqrtf(wave_sum(ss) * (1.0f / 512.0f) + EPS);
#pragma unroll
        for (int i = 0; i < 8; ++i) o[i] = o[i] * rstd * bf2f((unsigned short)g[i]);
        u32x4v w; w.x = pk2(o[0], o[1]); w.y = pk2(o[2], o[3]); w.z = pk2(o[4], o[5]); w.w = pk2(o[6], o[7]);
        *(u32x4v*)(OF + off) = w;
    }
}
typedef const __attribute__((address_space(4))) Args* KArgs;
__device__ __forceinline__ Args kargs() {
#if defined(__HIP_DEVICE_COMPILE__)
    KArgs p = (KArgs)__builtin_amdgcn_kernarg_segment_ptr(); asm volatile("" : "+s"(p)); return *p;
#else
    return Args{};
#endif
}
#define KA() const Args a = kargs(); unsigned char* const ws = a.ws; (void)ws
__global__ void __launch_bounds__(NTHR, 2) fwd_kernel(Args a_unused) {
    extern __shared__ __attribute__((aligned(16))) unsigned char lds_raw[];
    cg::grid_group grid = cg::this_grid();
    LAS unsigned char* lds = (LAS unsigned char*)lds_raw;
#ifndef PHM
#define PHM 0xFFFFFFFFu
#endif
#define PH(n) if ((PHM >> (n)) & 1u)
#define GSYNC_CG() do { asm volatile("s_waitcnt vmcnt(0) lgkmcnt(0)" ::: "memory"); grid.sync(); asm volatile("" ::: "memory"); } while (0)
#define GSYNC() do { for (int rs_ = 0; rs_ < REP_SYNC; ++rs_) { KA(); XcdBarrier xb_; xb_.bar = (unsigned*)(ws + WS_BAR); xb_.x = xb_xcc_id(); xb_.st = (volatile LAS unsigned*)(lds + LDS_CTL_OFF); xcd_barrier(xb_); asm volatile("" ::: "memory"); } } while (0)
#ifndef REP_SCAN
#define REP_SCAN 1
#endif
#ifndef REP_ATT
#define REP_ATT 1
#endif
#ifndef REP_W1
#define REP_W1 1
#endif
#ifndef REP_MN
#define REP_MN 1
#endif
#ifndef REP_CONV
#define REP_CONV 1
#endif
#ifndef REP_INP
#define REP_INP 1
#endif
#ifndef REP_ADA
#define REP_ADA 1
#endif
#ifndef REP_W2
#define REP_W2 1
#endif
#ifndef REP_SYNC
#define REP_SYNC 1
#endif
#define XP ((float*)(ws + WS_X))
#define XNP ((const bfu*)(ws + WS_XN))
#define MODSL ((const float*)(ws + WS_MODS) + (size_t)L * 9 * NMODW)
    if (otid() < 4) ((volatile LAS unsigned*)(lds + LDS_CTL_OFF))[otid()] = 0u;
    __syncthreads();
    { KA(); (void)xcd_barrier_post((unsigned*)(ws + WS_BAR), (volatile LAS unsigned*)(lds + LDS_CTL_OFF)); }
    PH(0) for (int rep = 0; rep < REP_ADA; ++rep) { KA(); phase_ada_rope(a, ws, lds); __syncthreads(); }
#pragma unroll 1
    for (int L = 0; L < DEPTH; ++L) {
        __syncthreads();
        PH(1) for (int rep = 0; rep < REP_CONV; ++rep) { KA(); phase_conv_weights(a, ws, lds, L); __syncthreads(); }
        if (L == 0) GSYNC_CG();
#pragma unroll 1
        for (int s = 0; s < 2; ++s) {
            PH(2) for (int rep = 0; rep < REP_MN; ++rep) { KA(); phase_modnorm(a, ws, L, s ? 2 : 0, (L == 0) && (s == 0), (s == 0 && L > 0) ? 2 : 0); }
            GSYNC();
            PH(3) for (int rep = 0; rep < REP_W1; ++rep) {   KA();
                pg8::Gemm g{XNP, (const bfu*)(ws + (s ? WS_W1B : WS_W1A)), MR, 2 * FFD, DM, DM}; pg8::StaticOrder S; S.init(MR, 2 * FFD, ogrid(), obid());
                pg8::EpiSwiglu E{(bfu*)(ws + WS_BIG)};
                pg8::gemm_phase<pg8::EpiSwiglu, pg8::StaticOrder, true, true>(lds, g, S, E);
            }
            GSYNC();
            PH(4) for (int rep = 0; rep < REP_W2; ++rep) {   KA();
                {   pg8::Gemm g{(const bfu*)(ws + WS_BIG), (const bfu*)(ws + (s ? WS_W2B : WS_W2A)), MR, DM, FFD, FFD}; pg8::LatentOrder S; S.init(MR / 256, DM, ogrid(), obid());
                    pg8::EpiResid E{XP, MODSL + (s ? 8 : 2) * DM, 0.5f / REP_W2, 0};
                    pg8::gemm_phase<pg8::EpiResid, pg8::LatentOrder, true, true>(lds, g, S, E); }
                if (!(s && L == DEPTH - 1)) {
                    pg8::Gemm g{(const bfu*)(ws + WS_BIG), (const bfu*)(ws + (s ? WS_W2B : WS_W2A)), MR, DM, FFD, 256}; pg8::CtxSplitOrder S; S.init(MR / 256, DM, FFD, 256, ogrid(), obid());
                    pg8::EpiPartial E{(float*)(ws + WS_BIG + BIG_PART), 512, NBATCH * CTXL};
                    pg8::gemm_phase<pg8::EpiPartial, pg8::CtxSplitOrder, true, true>(lds, g, S, E); }
            }
            GSYNC();
            if (s == 0) {
                PH(2) for (int rep = 0; rep < REP_MN; ++rep) { KA(); phase_modnorm(a, ws, L, 1, false, 1); }
                GSYNC();
                if ((L & 1) == 0) {
#pragma unroll 1
                    for (int hf = 0; hf < 2; ++hf) {
                        PH(5) for (int rep = 0; rep < REP_INP; ++rep) {   KA(); pg8::Gemm g{XNP + (size_t)hf * MH * DM, (const bfu*)(ws + WS_WMIX + WMIX_QKG), MH, 4096, DM, DM}; pg8::StaticOrder S; S.init(MH, 4096, ogrid(), obid());
                            pg8::EpiRetQKG E{(bfu*)(ws + WS_BIG + BIG_QKG), (const float*)(ws + WS_COSR), (const float*)(ws + WS_SINR), hf * HTILES};
                            pg8::gemm_phase<pg8::EpiRetQKG, pg8::StaticOrder, true, true>(lds, g, S, E); }
                        PH(6) for (int rep = 0; rep < REP_INP; ++rep) {   KA(); pg8::Gemm g{(const bfu*)(ws + WS_WMIX + WMIX_KV), XNP + (size_t)hf * MH * DM, 3072, MH, DM, DM}; pg8::StaticOrder S; S.init(3072, MH, ogrid(), obid());
                            pg8::EpiRetKVT E{(bfu*)(ws + WS_BIG + BIG_KVT), (const float*)(ws + WS_COSRT), (const float*)(ws + WS_SINRT), hf * HTILES};
                            pg8::gemm_phase<pg8::EpiRetKVT, pg8::StaticOrder, true, true>(lds, g, S, E); }
                        GSYNC();
                        PH(8) for (int rep = 0; rep < REP_SCAN; ++rep) { KA(); phase_ret_scan(a, ws, lds, L >> 1); }
                        GSYNC();
                        PH(9) { KA(); phase_ret_merge(ws); }
                        GSYNC();
                        PH(10) {   KA(); pg8::Gemm g{(const bfu*)(ws + WS_BIG + BIG_OF), (const bfu*)(ws + WS_WMIX + WMIX_OUT), MH, DM, 2048, 2048}; pg8::StaticOrder S; S.init(MH, DM, ogrid(), obid());
                            pg8::EpiResid E{XP, MODSL + 5 * DM, 1.0f, hf * HTILES};
                            pg8::gemm_phase<pg8::EpiResid, pg8::StaticOrder, true, true>(lds, g, S, E); }
                        GSYNC();
                    }
                } else {
                    PH(11) {   KA(); pg8::Gemm g{XNP, (const bfu*)(ws + WS_WMIX + WMIX_AQKV), MR, 1536, DM, DM}; pg8::StaticOrder S; S.init(MR, 1536, ogrid(), obid());
                        pg8::EpiPlain E{(bfu*)(ws + WS_BIG + BIG_AQKV), 1536};
                        pg8::gemm_phase<pg8::EpiPlain, pg8::StaticOrder, true, true>(lds, g, S, E); }
                    GSYNC();
                    PH(12) { KA(); phase_qknorm(a, ws, L >> 1); }
                    GSYNC();
                    PH(13) for (int rep = 0; rep < REP_ATT; ++rep) { KA(); phase_attention(ws, (char*)lds_raw); }
                    GSYNC();
                    PH(14) {   KA(); pg8::Gemm g{(const bfu*)(ws + WS_BIG + BIG_AO), (const bfu*)(ws + WS_WMIX + WMIX_AO), MR, DM, DM, DM}; pg8::StaticOrder S; S.init(MR, DM, ogrid(), obid());
                        pg8::EpiResid E{XP, MODSL + 5 * DM, 1.0f, 0};
                        pg8::gemm_phase<pg8::EpiResid, pg8::StaticOrder, true, true>(lds, g, S, E); }
                    GSYNC();
                }
            }
        }
    }
    PH(15) { KA(); phase_final(a, ws); }
}

extern "C" void kernel_launch(void* const* d_in, const int* in_sizes, int n_in, void* d_out, int out_size, void* d_ws, size_t ws_size, hipStream_t stream) {
    static int grid = 0;
    if (grid == 0) {
        if (n_in != 18 || out_size != NBATCH * SEQ * DM || ws_size < WS_END) { fprintf(stderr, "kernel_launch: unexpected shapes: n_in %d out %d ws %zu (need %zu)\n", n_in, out_size, ws_size, (size_t)WS_END); grid = -1; return; }
        int dev = 0, cus = 0;
        if (hipGetDevice(&dev) != hipSuccess || hipDeviceGetAttribute(&cus, hipDeviceAttributeMultiprocessorCount, dev) != hipSuccess) { grid = -1; return; }
        if (hipFuncSetAttribute((const void*)fwd_kernel, hipFuncAttributeMaxDynamicSharedMemorySize, LDS_BYTES) != hipSuccess) { fprintf(stderr, "kernel_launch: hipFuncSetAttribute failed\n"); grid = -1; return; }
        int per = 0;
        if (hipOccupancyMaxActiveBlocksPerMultiprocessor(&per, (const void*)fwd_kernel, NTHR, LDS_BYTES) != hipSuccess || per < 1) fprintf(stderr, "kernel_launch: occupancy query says %d\n", per);
        (void)hipGetLastError();
        grid = cus;
    }
    if (grid < 0) return;
    if (hipMemsetAsync((char*)d_ws + WS_BAR, 0, WS_BAR_BYTES, stream) != hipSuccess) { fprintf(stderr, "kernel_launch: memset of the barrier words failed\n"); return; }
    Args a{};
    const float** ap = (const float**)&a;
    for (int i = 0; i < 18; ++i) ap[i] = (const float*)d_in[i];
    a.out = (float*)d_out; a.ws = (unsigned char*)d_ws;
    void* args[] = {&a};
    hipError_t e = hipLaunchCooperativeKernel((const void*)fwd_kernel, dim3(grid), dim3(NTHR), args, LDS_BYTES, stream);
    if (e != hipSuccess) fprintf(stderr, "kernel_launch: cooperative launch failed: %s (grid %d)\n", hipGetErrorString(e), grid);
}
```

```cpp
#include <hip/hip_runtime.h>
#include <hip/hip_cooperative_groups.h>
#include <hip/hip_bf16.h>
#include <cstdio>
#include <cstdint>
namespace cg = cooperative_groups;
__device__ __forceinline__ int otid() { int t = threadIdx.x; asm volatile("" : "+v"(t)); return t; }
__device__ __forceinline__ int obid() { int t = blockIdx.x; asm volatile("" : "+s"(t)); return t; }
__device__ __forceinline__ int ogrid() { int t = gridDim.x; asm volatile("" : "+s"(t)); return t; }
namespace pg8 {
#define PG8_LAS __attribute__((address_space(3)))
typedef unsigned short bf16_t;
typedef short bf16x8 __attribute__((ext_vector_type(8)));
typedef float f32x4 __attribute__((ext_vector_type(4)));
typedef unsigned u32x4 __attribute__((ext_vector_type(4)));
constexpr int BM = 256, BK = 64, HALF = 128, HTB = HALF * BK * 2  , STAGE_BYTES = 8 * HTB, NXCD = 8, WGM = 8;

__host__ __device__ __forceinline__ int lds_byte(int r, int c) { const int st = (r >> 4) * 2 + (c >> 5), rr = r & 15, cc = c & 31, ob = rr * 64 + cc * 2; return st * 1024 + (ob ^ (((ob >> 9) & 1) << 5)); }
__host__ __device__ __forceinline__ void stage_rc(int b, int& R, int& C) { const int st = b / 1024, sb = b % 1024, swz = sb ^ (((sb >> 9) & 1) << 5); R = (st >> 1) * 16 + swz / 64; C = (st & 1) * 32 + (swz % 64) / 2; }
__host__ __device__ __forceinline__ int perm32(int rho) { const int n = rho >> 4, i = rho & 15; return 8 * (i >> 2) + 4 * n + (i & 3); }

struct Unit { int pm, pn, kb; };
struct Gemm { const bf16_t* A; const bf16_t* Bt; int M, N, K, Kl; };

struct StaticOrder {
    int nM, nN, nwg, G, c;
    __host__ __device__ void init(int M, int N, int G_, int c_) { nM = M / BM; nN = N / BM; nwg = nM * nN; G = G_; c = c_; }
    __host__ __device__ bool next(int i, Unit& u) const {
        const long L = (long)i * G + c; if (L >= nwg) return false;
        int wgid = (int)L; { const int q = nwg / NXCD, r = nwg % NXCD, xcd = wgid % NXCD, off = wgid / NXCD; wgid = (xcd < r ? xcd * (q + 1) : r * (q + 1) + (xcd - r) * q) + off; }
        const int nig = WGM * nN, gid = wgid / nig, fm = gid * WGM, gsz = (nM - fm) < WGM ? (nM - fm) : WGM;
        u.pm = fm + ((wgid % nig) % gsz); u.pn = (wgid % nig) / gsz; u.kb = 0; return true;
    }
    __device__ __forceinline__ void a_ready(const Unit&) const {}
    __device__ __forceinline__ void done(const Unit&) const {}
};

struct LatentOrder {
    StaticOrder so;
    __host__ __device__ void init(int Mtiles_all, int N, int G_, int c_) { so.init((Mtiles_all / 17) * 16 * BM, N, G_, c_); }
    __host__ __device__ bool next(int i, Unit& u) const { if (!so.next(i, u)) return false; u.pm = u.pm + (u.pm >> 4); return true; }
    __device__ __forceinline__ void a_ready(const Unit&) const {}
    __device__ __forceinline__ void done(const Unit&) const {}
};
struct CtxSplitOrder {
    int nctx, nN, nks, klb, G, c;
    __host__ __device__ void init(int Mtiles_all, int N, int K, int kl, int G_, int c_) { nctx = Mtiles_all / 17; nN = N / BM; nks = K / kl; klb = kl * 2; G = G_; c = c_; }
    __host__ __device__ bool next(int i, Unit& u) const {
        const int L = i * G + c; const int per = nctx * nN; if (L >= per * nks) return false;
        const int ks = L / per, t = L - ks * per; u.pn = t % nN; u.pm = 17 * (t / nN) + 16; u.kb = ks * klb; return true;
    }
    __device__ __forceinline__ void a_ready(const Unit&) const {}
    __device__ __forceinline__ void done(const Unit&) const {}
};
__device__ __forceinline__ unsigned cvt_pk_bf16(float lo, float hi) { unsigned r; asm volatile("v_cvt_pk_bf16_f32 %0, %1, %2" : "=v"(r) : "v"(lo), "v"(hi)); return r; }
typedef float f32x2 __attribute__((ext_vector_type(2)));
constexpr int DM = 1024, NBATCH = 8, SEQ = 4096, CTXL = 256, RPB = SEQ + CTXL, MR = NBATCH * RPB, MH = MR / 2, TPB = RPB / 256, HTILES = MH / 256;
constexpr int FFD = 2816, NMODW = 9 * DM;
__device__ __forceinline__ float bf2f(unsigned short s) { return __uint_as_float(((unsigned)s) << 16); }
__device__ __forceinline__ float fast_silu(float x) { return x * __builtin_amdgcn_rcpf(1.0f + __builtin_amdgcn_exp2f(-1.4426950408889634f * x)); }

struct EpiSwiglu {
    static constexpr bool PERM = true, AFTER_DRAIN = false;
    bf16_t* H;
    __device__ __forceinline__ void operator()(const f32x4 (&acc)[2][2][4][2], const Unit& u, int wr, int wc, int fr, int fq) const {
        const int row0 = u.pm * BM + wr * 64 + fr; const int col0 = u.pn * HALF + wc * 32 + 8 * fq;
#pragma unroll
        for (int ai = 0; ai < 2; ++ai)
#pragma unroll
            for (int m = 0; m < 4; ++m) {
                bf16_t* rowp = H + (size_t)(row0 + ai * HALF + m * 16) * FFD + col0;
                const f32x4 g0 = acc[ai][0][m][0], g1 = acc[ai][0][m][1], u0 = acc[ai][1][m][0], u1 = acc[ai][1][m][1];
                u32x4 w;
                w.x = cvt_pk_bf16(fast_silu(g0[0]) * u0[0], fast_silu(g0[1]) * u0[1]); w.y = cvt_pk_bf16(fast_silu(g0[2]) * u0[2], fast_silu(g0[3]) * u0[3]);
                w.z = cvt_pk_bf16(fast_silu(g1[0]) * u1[0], fast_silu(g1[1]) * u1[1]); w.w = cvt_pk_bf16(fast_silu(g1[2]) * u1[2], fast_silu(g1[3]) * u1[3]);
                *(u32x4*)rowp = w;
            }
    }
};
struct EpiResid {
    static constexpr bool PERM = true, AFTER_DRAIN = false;
    float* X; const float* gate  ; float gs; int pm_off;
    __device__ __forceinline__ void operator()(const f32x4 (&acc)[2][2][4][2], const Unit& u, int wr, int wc, int fr, int fq) const {
        const int pmg = u.pm + pm_off; const int bb = pmg / TPB, within = pmg - bb * TPB; const int mrow = (within == TPB - 1) ? 8 : bb;
        const int col0 = u.pn * BM + wc * 32 + 8 * fq; const float* gp = gate + (size_t)mrow * NMODW + col0;
        f32x4 gv[2][2];
#pragma unroll
        for (int bj = 0; bj < 2; ++bj)
#pragma unroll
            for (int n = 0; n < 2; ++n) gv[bj][n] = *(const f32x4*)(gp + bj * HALF + n * 4) * gs;
        const int row0 = pmg * BM + wr * 64 + fr;
#pragma unroll
        for (int ai = 0; ai < 2; ++ai)
#pragma unroll
            for (int m = 0; m < 4; ++m) {
                float* rowp = X + (size_t)(row0 + ai * HALF + m * 16) * DM + col0;
#pragma unroll
                for (int bj = 0; bj < 2; ++bj)
#pragma unroll
                    for (int n = 0; n < 2; ++n) { f32x4* p = (f32x4*)(rowp + bj * HALF + n * 4); *p = *p + gv[bj][n] * acc[ai][bj][m][n]; }
            }
    }
};
struct EpiPartial {
    static constexpr bool PERM = true, AFTER_DRAIN = false;
    float* P; int klb, nrows;
    __device__ __forceinline__ void operator()(const f32x4 (&acc)[2][2][4][2], const Unit& u, int wr, int wc, int fr, int fq) const {
        const int ks = u.kb / klb, ci = u.pm / TPB; const int col0 = u.pn * BM + wc * 32 + 8 * fq;
        float* base = P + ((size_t)ks * nrows + ci * BM + wr * 64 + fr) * DM + col0;
#pragma unroll
        for (int ai = 0; ai < 2; ++ai)
#pragma unroll
            for (int m = 0; m < 4; ++m) { float* rowp = base + (size_t)(ai * HALF + m * 16) * DM;
#pragma unroll
                for (int bj = 0; bj < 2; ++bj) { *(f32x4*)(rowp + bj * HALF) = acc[ai][bj][m][0]; *(f32x4*)(rowp + bj * HALF + 4) = acc[ai][bj][m][1]; } }
    }
};
struct EpiPlain {
    static constexpr bool PERM = true, AFTER_DRAIN = false;
    bf16_t* O; int ldc;
    __device__ __forceinline__ void operator()(const f32x4 (&acc)[2][2][4][2], const Unit& u, int wr, int wc, int fr, int fq) const {
        const int row0 = u.pm * BM + wr * 64 + fr; const int col0 = u.pn * BM + wc * 32 + 8 * fq;
#pragma unroll
        for (int ai = 0; ai < 2; ++ai)
#pragma unroll
            for (int m = 0; m < 4; ++m) { bf16_t* rowp = O + (size_t)(row0 + ai * HALF + m * 16) * ldc + col0;
#pragma unroll
                for (int bj = 0; bj < 2; ++bj) { const f32x4 v0 = acc[ai][bj][m][0], v1 = acc[ai][bj][m][1]; u32x4 w;
                    w.x = cvt_pk_bf16(v0[0], v0[1]); w.y = cvt_pk_bf16(v0[2], v0[3]); w.z = cvt_pk_bf16(v1[0], v1[1]); w.w = cvt_pk_bf16(v1[2], v1[3]);
                    *(u32x4*)(rowp + bj * HALF) = w; } }
    }
};
struct EpiRetQKG {
    static constexpr bool PERM = true, AFTER_DRAIN = false;
    bf16_t* O; const float* cosR; const float* sinR;   int pm_off;
    __device__ __forceinline__ void operator()(const f32x4 (&acc)[2][2][4][2], const Unit& u, int wr, int wc, int fr, int fq) const {
        const int pmg = u.pm + pm_off; const int bb = pmg / TPB, within = pmg - bb * TPB; const bool latent = within < TPB - 1;
        const int row0 = u.pm * BM + wr * 64 + fr; const int jc = wc * 32 + 8 * fq; const int col0 = u.pn * BM + jc;
        const bool isg = u.pn >= 8;
#pragma unroll
        for (int ai = 0; ai < 2; ++ai)
#pragma unroll
            for (int m = 0; m < 4; ++m) {
                const int rl = ai * HALF + wr * 64 + m * 16 + fr;
                bf16_t* rowp = O + (size_t)(u.pm * BM + rl) * 4096 + col0;
                f32x4 a0 = acc[ai][0][m][0], a1 = acc[ai][0][m][1], b0 = acc[ai][1][m][0], b1 = acc[ai][1][m][1];
                if (isg) {
#pragma unroll
                    for (int i = 0; i < 4; ++i) { a0[i] = fast_silu(a0[i]); a1[i] = fast_silu(a1[i]); b0[i] = fast_silu(b0[i]); b1[i] = fast_silu(b1[i]); }
                } else if (latent) {
                    const int pos = within * BM + rl;
                    const f32x4 c0 = *(const f32x4*)(cosR + (size_t)pos * 128 + jc), c1 = *(const f32x4*)(cosR + (size_t)pos * 128 + jc + 4);
                    const f32x4 s0 = *(const f32x4*)(sinR + (size_t)pos * 128 + jc), s1 = *(const f32x4*)(sinR + (size_t)pos * 128 + jc + 4);
                    const f32x4 x0 = a0 * c0 - b0 * s0, y0 = b0 * c0 + a0 * s0, x1 = a1 * c1 - b1 * s1, y1 = b1 * c1 + a1 * s1;
                    a0 = x0; b0 = y0; a1 = x1; b1 = y1;
                }
                u32x4 w; w.x = cvt_pk_bf16(a0[0], a0[1]); w.y = cvt_pk_bf16(a0[2], a0[3]); w.z = cvt_pk_bf16(a1[0], a1[1]); w.w = cvt_pk_bf16(a1[2], a1[3]);
                *(u32x4*)rowp = w;
                w.x = cvt_pk_bf16(b0[0], b0[1]); w.y = cvt_pk_bf16(b0[2], b0[3]); w.z = cvt_pk_bf16(b1[0], b1[1]); w.w = cvt_pk_bf16(b1[2], b1[3]);
                *(u32x4*)(rowp + HALF) = w;
            }
        (void)row0;
    }
};
struct EpiRetKVT {
    static constexpr bool PERM = true, AFTER_DRAIN = false;
    bf16_t* O; const float* cosT; const float* sinT;   int pn_off;
    __device__ __forceinline__ void operator()(const f32x4 (&acc)[2][2][4][2], const Unit& u, int wr, int wc, int fr, int fq) const {
        const int png = u.pn + pn_off; const int bb = png / TPB, within = png - bb * TPB; const bool rot = (within < TPB - 1) && (u.pm < 4);
        const int tc = wc * 32 + 8 * fq;
#pragma unroll
        for (int m = 0; m < 4; ++m) {
            const int j = wr * 64 + m * 16 + fr;
#pragma unroll
            for (int bj = 0; bj < 2; ++bj) {
                f32x4 a0 = acc[0][bj][m][0], a1 = acc[0][bj][m][1], b0 = acc[1][bj][m][0], b1 = acc[1][bj][m][1];
                if (rot) {
                    const int pos = within * BM + bj * HALF + tc;
                    const f32x4 c0 = *(const f32x4*)(cosT + (size_t)j * SEQ + pos), c1 = *(const f32x4*)(cosT + (size_t)j * SEQ + pos + 4);
                    const f32x4 s0 = *(const f32x4*)(sinT + (size_t)j * SEQ + pos), s1 = *(const f32x4*)(sinT + (size_t)j * SEQ + pos + 4);
                    const f32x4 x0 = a0 * c0 - b0 * s0, y0 = b0 * c0 + a0 * s0, x1 = a1 * c1 - b1 * s1, y1 = b1 * c1 + a1 * s1;
                    a0 = x0; b0 = y0; a1 = x1; b1 = y1;
                }
                bf16_t* p0 = O + (size_t)(u.pm * BM + j) * MH + u.pn * BM + bj * HALF + tc;
                u32x4 w; w.x = cvt_pk_bf16(a0[0], a0[1]); w.y = cvt_pk_bf16(a0[2], a0[3]); w.z = cvt_pk_bf16(a1[0], a1[1]); w.w = cvt_pk_bf16(a1[2], a1[3]);
                *(u32x4*)p0 = w;
                w.x = cvt_pk_bf16(b0[0], b0[1]); w.y = cvt_pk_bf16(b0[2], b0[3]); w.z = cvt_pk_bf16(b1[0], b1[1]); w.w = cvt_pk_bf16(b1[2], b1[3]);
                *(u32x4*)(p0 + (size_t)HALF * MH) = w;
            }
        }
    }
};
template <class Epi, class Sched, bool ALIGN_EPI = false, bool SP2 = false>
__device__ __forceinline__ void gemm_phase(PG8_LAS unsigned char* lds, const Gemm g, const Sched& S, const Epi& E) {
    const int tid = otid(), wid = __builtin_amdgcn_readfirstlane(tid >> 6), lane = tid & 63, wr = wid >> 2, wc = wid & 3, fr = lane & 15, fq = lane >> 4;
    const int K = g.K, nt = g.Kl / BK;
    unsigned voffA[2], voffB[2];
#pragma unroll
    for (int i = 0; i < 2; ++i) { int R, C; stage_rc(tid * 16 + i * 8192, R, C); const int Rb = Epi::PERM ? ((R & ~31) + perm32(R & 31)) : R;
        voffA[i] = (unsigned)(R * K + C) * 2u; voffB[i] = (unsigned)(Rb * K + C) * 2u; }
    const size_t kstep = (size_t)(BK * 2);
    const size_t hstep = (size_t)HALF * K * 2;
    const size_t tstep = 2 * hstep;
    const unsigned ldsw = (unsigned)wid * 1024u;
    const int aoff = lds_byte(wr * 64 + fr, fq * 8), boff = lds_byte(wc * 32 + fr, fq * 8);
#define PG8_SA(b, h) (((b) * 2 + (h)) * HTB)
#define PG8_SB(b, h) ((4 + (b) * 2 + (h)) * HTB)
#define PG8_STAGE(bufoff, gbase, voff) do { _Pragma("unroll") for (int _i = 0; _i < 2; ++_i) \
        __builtin_amdgcn_global_load_lds((const unsigned*)((const char*)(gbase) + (voff)[_i]), (PG8_LAS unsigned*)(lds + (bufoff) + ldsw + _i * 8192), 16, 0, 0); } while (0)
#define PG8_LDA(dst, b, h) do { _Pragma("unroll") for (int m = 0; m < 4; ++m) _Pragma("unroll") for (int k = 0; k < 2; ++k) dst[m][k] = *(const PG8_LAS bf16x8*)(lds + PG8_SA(b, h) + aoff + m * 2048 + k * 1024); } while (0)
#define PG8_LDB(dst, b, h) do { _Pragma("unroll") for (int n = 0; n < 2; ++n) _Pragma("unroll") for (int k = 0; k < 2; ++k) dst[n][k] = *(const PG8_LAS bf16x8*)(lds + PG8_SB(b, h) + boff + n * 2048 + k * 1024); } while (0)
#define PG8_MMA(ai, bj, At, Bt) do { __builtin_amdgcn_s_setprio(1); _Pragma("unroll") for (int m = 0; m < 4; ++m) _Pragma("unroll") for (int n = 0; n < 2; ++n) _Pragma("unroll") for (int k = 0; k < 2; ++k) \
        acc[ai][bj][m][n] = __builtin_amdgcn_mfma_f32_16x16x32_bf16(Bt[n][k], At[m][k], acc[ai][bj][m][n], 0, 0, 0); __builtin_amdgcn_s_setprio(0); } while (0)
#define PG8_WAIT_V(n) asm volatile("s_waitcnt vmcnt(" #n ")" ::: "memory")
#define PG8_WAIT_L(n) asm volatile("s_waitcnt lgkmcnt(" #n ")" ::: "memory")
#define PG8_BAR __builtin_amdgcn_s_barrier()
#define PG8_SCHED __builtin_amdgcn_sched_barrier(0)
    Unit cur, nxt; int ui = 0;
    if (!S.next(0, cur)) return;
    f32x4 acc[2][2][4][2];
#pragma unroll
    for (int a = 0; a < 2; ++a)
#pragma unroll
        for (int b = 0; b < 2; ++b)
#pragma unroll
            for (int m = 0; m < 4; ++m)
#pragma unroll
                for (int n = 0; n < 2; ++n) acc[a][b][m][n] = (f32x4){0.f, 0.f, 0.f, 0.f};
    bf16x8 At[4][2], B0[2][2], B1[2][2];
    const char* cA = (const char*)g.A + (size_t)cur.pm * tstep + cur.kb; const char* cB = (const char*)g.Bt + (size_t)cur.pn * tstep + cur.kb;
    S.a_ready(cur);
    if constexpr (SP2) {
        PG8_STAGE(PG8_SB(0, 0), cB, voffB); PG8_STAGE(PG8_SB(0, 1), cB + hstep, voffB); PG8_STAGE(PG8_SA(0, 0), cA, voffA); PG8_STAGE(PG8_SA(0, 1), cA + hstep, voffA);
        if (wr == 1) PG8_BAR;
        PG8_WAIT_V(2); PG8_BAR;
        PG8_STAGE(PG8_SB(1, 0), cB + kstep, voffB); PG8_STAGE(PG8_SA(1, 0), cA + kstep, voffA); PG8_STAGE(PG8_SB(1, 1), cB + hstep + kstep, voffB);
        PG8_WAIT_V(6); PG8_BAR;
    } else {
        PG8_STAGE(PG8_SB(0, 0), cB, voffB); PG8_STAGE(PG8_SA(0, 0), cA, voffA); PG8_STAGE(PG8_SB(0, 1), cB + hstep, voffB); PG8_STAGE(PG8_SA(0, 1), cA + hstep, voffA);
        if (wr == 1) PG8_BAR;
        PG8_WAIT_V(4); PG8_BAR;
        PG8_STAGE(PG8_SB(1, 0), cB + kstep, voffB); PG8_STAGE(PG8_SA(1, 0), cA + kstep, voffA); PG8_STAGE(PG8_SB(1, 1), cB + hstep + kstep, voffB);
        PG8_WAIT_V(6); PG8_BAR;
    }
    for (;;) {
        const bool has_next = S.next(ui + 1, nxt);
        const char* nA = has_next ? (const char*)g.A + (size_t)nxt.pm * tstep + nxt.kb : cA; const char* nB = has_next ? (const char*)g.Bt + (size_t)nxt.pn * tstep + nxt.kb : cB;
        for (int t = 0; t < nt; t += 2) {
            const bool last = (t == nt - 2);
            const char* a1 = cA + (size_t)(t + 1) * kstep;
            const char* a2 = last ? nA : cA + (size_t)(t + 2) * kstep; const char* b2 = last ? nB : cB + (size_t)(t + 2) * kstep;
            const char* a3 = a2 + kstep; const char* b3 = b2 + kstep;
            if (last && has_next) S.a_ready(nxt);
            if constexpr (SP2) {
            PG8_LDB(B0, 0, 0); PG8_LDB(B1, 0, 1); PG8_SCHED; PG8_LDA(At, 0, 0); PG8_STAGE(PG8_SA(1, 1), a1 + hstep, voffA);
            PG8_WAIT_V(8); PG8_WAIT_L(0); PG8_BAR; PG8_MMA(0, 0, At, B0); PG8_MMA(0, 1, At, B1); PG8_BAR; PG8_SCHED;
            PG8_LDA(At, 0, 1); PG8_STAGE(PG8_SB(0, 0), b2, voffB); PG8_STAGE(PG8_SB(0, 1), b2 + hstep, voffB); PG8_STAGE(PG8_SA(0, 0), a2, voffA);
            PG8_WAIT_V(8); PG8_WAIT_L(0); PG8_BAR; PG8_MMA(1, 0, At, B0); PG8_MMA(1, 1, At, B1); PG8_BAR; PG8_SCHED;
            PG8_LDB(B0, 1, 0); PG8_LDB(B1, 1, 1); PG8_SCHED; PG8_LDA(At, 1, 0); PG8_STAGE(PG8_SA(0, 1), a2 + hstep, voffA);
            PG8_WAIT_V(8); PG8_WAIT_L(0); PG8_BAR; PG8_MMA(0, 0, At, B0); PG8_MMA(0, 1, At, B1); PG8_BAR; PG8_SCHED;
            PG8_LDA(At, 1, 1); PG8_STAGE(PG8_SB(1, 0), b3, voffB); PG8_STAGE(PG8_SB(1, 1), b3 + hstep, voffB); PG8_STAGE(PG8_SA(1, 0), a3, voffA);
            PG8_WAIT_V(8); PG8_WAIT_L(0); PG8_BAR; PG8_MMA(1, 0, At, B0); PG8_MMA(1, 1, At, B1); PG8_BAR; PG8_SCHED;
            } else {
            PG8_LDB(B0, 0, 0); PG8_SCHED; PG8_LDA(At, 0, 0); PG8_STAGE(PG8_SA(1, 1), a1 + hstep, voffA);
            PG8_WAIT_L(8); PG8_BAR; PG8_WAIT_L(0); PG8_MMA(0, 0, At, B0); PG8_BAR; PG8_SCHED;
            PG8_LDB(B1, 0, 1); PG8_STAGE(PG8_SB(0, 0), b2, voffB);
            PG8_BAR; PG8_WAIT_L(0); PG8_MMA(0, 1, At, B1); PG8_BAR;
            PG8_LDA(At, 0, 1); PG8_STAGE(PG8_SA(0, 0), a2, voffA);
            PG8_BAR; PG8_WAIT_L(0); PG8_MMA(1, 0, At, B0); PG8_BAR; PG8_SCHED;
            PG8_STAGE(PG8_SB(0, 1), b2 + hstep, voffB);
            PG8_WAIT_V(6); PG8_BAR; PG8_MMA(1, 1, At, B1); PG8_BAR;
            PG8_LDB(B0, 1, 0); PG8_SCHED; PG8_LDA(At, 1, 0); PG8_STAGE(PG8_SA(0, 1), a2 + hstep, voffA);
            PG8_WAIT_L(8); PG8_BAR; PG8_WAIT_L(0); PG8_MMA(0, 0, At, B0); PG8_BAR; PG8_SCHED;
            PG8_LDB(B1, 1, 1); PG8_STAGE(PG8_SB(1, 0), b3, voffB);
            PG8_BAR; PG8_WAIT_L(0); PG8_MMA(0, 1, At, B1); PG8_BAR;
            PG8_LDA(At, 1, 1); PG8_STAGE(PG8_SA(1, 0), a3, voffA);
            PG8_BAR; PG8_WAIT_L(0); PG8_MMA(1, 0, At, B0); PG8_BAR; PG8_SCHED;
            PG8_STAGE(PG8_SB(1, 1), b3 + hstep, voffB);
            PG8_WAIT_V(6); PG8_BAR; PG8_MMA(1, 1, At, B1); PG8_BAR;
            }
        }
        if constexpr (ALIGN_EPI) { if (wr == 0) PG8_BAR; }
        if constexpr (!Epi::AFTER_DRAIN) { asm volatile("s_nop 15\n\ts_nop 7" ::: "memory");
            E(acc, cur, wr, wc, fr, fq); S.done(cur); }
        if (!has_next) break;
#pragma unroll
        for (int a = 0; a < 2; ++a)
#pragma unroll
            for (int b = 0; b < 2; ++b)
#pragma unroll
                for (int m = 0; m < 4; ++m)
#pragma unroll
                    for (int n = 0; n < 2; ++n) acc[a][b][m][n] = (f32x4){0.f, 0.f, 0.f, 0.f};
        cur = nxt; cA = nA; cB = nB; ++ui;
        if constexpr (ALIGN_EPI) { if (wr == 1) PG8_BAR; }
    }
    PG8_WAIT_V(0);
    if constexpr (!ALIGN_EPI) { if (wr == 0) PG8_BAR; }
    PG8_BAR;
    if constexpr (Epi::AFTER_DRAIN) { E.fused(acc, cur, wr, wc, fr, fq, lds, wid, lane); S.done(cur); }
#undef PG8_SA
#undef PG8_SB
#undef PG8_STAGE
#undef PG8_LDA
#undef PG8_LDB
#undef PG8_MMA
#undef PG8_WAIT_V
#undef PG8_WAIT_L
#undef PG8_BAR
#undef PG8_SCHED
}
}

namespace attn {
using bf16 = __hip_bfloat16;
constexpr int D = 128, NW = 8, QBLK = 32, KVBLK = 64;
constexpr float SCALE = 0.088388347648318440f;
constexpr float THR = 8.f;
constexpr int LDQ = 1536, LDK = 1536, LDO = 1024;
constexpr size_t SHM_V = KVBLK * D * 2, SHM_K = KVBLK * D * 2, SHM_ATTN = 2 * SHM_V + 2 * SHM_K + NW * 64 * 4;
using bf16x8 = __attribute__((ext_vector_type(8))) short;
using s16x4  = __attribute__((ext_vector_type(4))) short;
using f32x16 = __attribute__((ext_vector_type(16))) float;
using u32x4  = __attribute__((ext_vector_type(4))) unsigned;
#define KSWZ(row, colB) ((row) * 256 + ((colB) ^ (((row) & 7) << 4)))
#define SBAR() __builtin_amdgcn_sched_barrier(0)
__device__ __forceinline__ int crow(int r, int hi) { return (r & 3) + 8 * (r >> 2) + 4 * hi; }
__device__ __forceinline__ unsigned cvtpk(float lo, float hi) { unsigned r; asm volatile("v_cvt_pk_bf16_f32 %0, %1, %2" : "=v"(r) : "v"(lo), "v"(hi)); return r; }
__device__ __forceinline__ void partialSM(f32x16& p0, f32x16& p1, float& m_reg, float& mn, float& alpha) {
  constexpr float C = SCALE * 1.4426950408889634f;
  float pmax = p0[0]; for (int r = 1; r < 16; ++r) pmax = fmaxf(pmax, p0[r]); for (int r = 0; r < 16; ++r) pmax = fmaxf(pmax, p1[r]);
  { auto rr = __builtin_amdgcn_permlane32_swap(__float_as_uint(pmax), __float_as_uint(pmax), false, false);
    pmax = fmaxf(__uint_as_float(rr[0]), __uint_as_float(rr[1])); }
  if (__builtin_expect(__all(pmax - m_reg <= THR / SCALE), 1)) { mn = m_reg; alpha = 1.f; }
  else { mn = fmaxf(m_reg, pmax); alpha = __builtin_amdgcn_exp2f((m_reg - mn) * C); m_reg = mn; }
  float mnC = -mn * C;
  for (int r = 0; r < 16; ++r) p0[r] = fmaf(p0[r], C, mnC); for (int r = 0; r < 16; ++r) p1[r] = fmaf(p1[r], C, mnC);
  for (int r = 0; r < 16; ++r) p0[r] = __builtin_amdgcn_exp2f(p0[r]);
}
__device__ __forceinline__ void finishSM(f32x16& p0, f32x16& p1, float alpha, float& l_reg, bf16x8& pa0, bf16x8& pa1, bf16x8& pa2, bf16x8& pa3) {
  for (int r = 0; r < 16; ++r) p1[r] = __builtin_amdgcn_exp2f(p1[r]);
  float ps = 0; for (int r = 0; r < 16; ++r) ps += p0[r]; for (int r = 0; r < 16; ++r) ps += p1[r];
  { auto rr = __builtin_amdgcn_permlane32_swap(__float_as_uint(ps), __float_as_uint(ps), false, false);
    ps = __uint_as_float(rr[0]) + __uint_as_float(rr[1]); }
  l_reg = l_reg * alpha + ps;
#define PK4(P, BASE, OUT) do { unsigned a0 = cvtpk(P[BASE + 0], P[BASE + 1]), a1 = cvtpk(P[BASE + 2], P[BASE + 3]);   \
    unsigned b0 = cvtpk(P[BASE + 4], P[BASE + 5]), b1 = cvtpk(P[BASE + 6], P[BASE + 7]);                              \
    auto r0 = __builtin_amdgcn_permlane32_swap(a0, b0, false, false); auto r1 = __builtin_amdgcn_permlane32_swap(a1, b1, false, false); \
    u32x4 w = {r0[0], r1[0], r0[1], r1[1]}; OUT = *reinterpret_cast<bf16x8*>(&w); } while (0)
  PK4(p0, 0, pa0); PK4(p0, 8, pa1); PK4(p1, 0, pa2); PK4(p1, 8, pa3);
#undef PK4
}
__device__ __forceinline__ void qkt(f32x16& p0, f32x16& p1, const bf16* Ks, const bf16x8* qr, int r32, int hi) {
  p0 = f32x16{}; p1 = f32x16{};
  for (int d0 = 0; d0 < 8; ++d0) { int cb = (d0 * 16 + hi * 8) * 2;
    bf16x8 b0 = *reinterpret_cast<const bf16x8*>((const char*)Ks + KSWZ(r32, cb));
    bf16x8 b1 = *reinterpret_cast<const bf16x8*>((const char*)Ks + KSWZ(32 + r32, cb));
    p0 = __builtin_amdgcn_mfma_f32_32x32x16_bf16(b0, qr[d0], p0, 0, 0, 0);
    p1 = __builtin_amdgcn_mfma_f32_32x32x16_bf16(b1, qr[d0], p1, 0, 0, 0); }
}
__device__ __forceinline__ int v_st(int k, int c) { const int kk = (k & ~0xC) | ((k & 4) << 1) | ((k & 8) >> 1); return ((kk >> 3) * 4 + (c >> 5)) * 512 + ((kk & 7) * 32 + (c & 31)) * 2; }
__device__ __forceinline__ int v_rd_base(int lane) { return ((lane & 3) << 3) | (((lane >> 2) & 3) << 6) | (((lane >> 4) & 1) << 5) | (((lane >> 5) & 1) << 8); }
constexpr int v_rd_off(int d0, int ks, int half) { return d0 * 512 + ks * 4096 + half * 2048; }
template <int OFF> __device__ __forceinline__ s16x4 tr_read(int vb) {
  s16x4 r; asm volatile("ds_read_b64_tr_b16 %0, %1 offset:%2" : "=&v"(r) : "v"(vb), "i"(OFF) : "memory"); return r;
}
template <int D0> __device__ __forceinline__ void pv_one(f32x16& od, int vb, bf16x8 pa0, bf16x8 pa1, bf16x8 pa2, bf16x8 pa3) {
  const s16x4 l0 = tr_read<v_rd_off(D0, 0, 0)>(vb), h0 = tr_read<v_rd_off(D0, 0, 1)>(vb), l1 = tr_read<v_rd_off(D0, 1, 0)>(vb), h1 = tr_read<v_rd_off(D0, 1, 1)>(vb);
  const s16x4 l2 = tr_read<v_rd_off(D0, 2, 0)>(vb), h2 = tr_read<v_rd_off(D0, 2, 1)>(vb), l3 = tr_read<v_rd_off(D0, 3, 0)>(vb), h3 = tr_read<v_rd_off(D0, 3, 1)>(vb);
  asm volatile("s_waitcnt lgkmcnt(0)" ::: "memory"); SBAR();
#define PK(L, H) (bf16x8){L[0], L[1], L[2], L[3], H[0], H[1], H[2], H[3]}
  od = __builtin_amdgcn_mfma_f32_32x32x16_bf16(pa0, PK(l0, h0), od, 0, 0, 0);
  od = __builtin_amdgcn_mfma_f32_32x32x16_bf16(pa1, PK(l1, h1), od, 0, 0, 0);
  od = __builtin_amdgcn_mfma_f32_32x32x16_bf16(pa2, PK(l2, h2), od, 0, 0, 0);
  od = __builtin_amdgcn_mfma_f32_32x32x16_bf16(pa3, PK(l3, h3), od, 0, 0, 0);
#undef PK
}
__device__ __forceinline__ void pv_d0(f32x16* o, int vb, bf16x8 pa0, bf16x8 pa1, bf16x8 pa2, bf16x8 pa3) {
  pv_one<0>(o[0], vb, pa0, pa1, pa2, pa3); pv_one<1>(o[1], vb, pa0, pa1, pa2, pa3); pv_one<2>(o[2], vb, pa0, pa1, pa2, pa3); pv_one<3>(o[3], vb, pa0, pa1, pa2, pa3);
}
__device__ __forceinline__ void attn_dense_body(const bf16* __restrict__ Qb, const bf16* __restrict__ Kh, const bf16* __restrict__ Vh,
                                                bf16* __restrict__ Ob, int seq, char* lds) {
  constexpr int SDEPTH = 2;
  const int tid = otid(), wid = tid >> 6, lane = tid & 63, r32 = lane & 31, hi = lane >> 5;
  bf16* V_lds = (bf16*)lds; bf16* K_lds = (bf16*)(lds + 2 * SHM_V);
  float* ws = (float*)(lds + 2 * SHM_V + 2 * SHM_K) + wid * 64; float* li_l = ws; float* al_l = ws + 32;
  float m_reg = -1e30f, l_reg = 0; f32x16 o[4] = {}; bf16x8 qr[8];
  const bf16* Qw = Qb + (long)(wid * QBLK + r32) * LDQ + hi * 8;
#pragma unroll
  for (int d0 = 0; d0 < 8; ++d0) qr[d0] = *reinterpret_cast<const bf16x8*>(Qw + d0 * 16);
  const int sr = tid >> 4, sc = (tid & 15) * 8, vst0 = v_st(sr, sc), vst1 = v_st(32 + sr, sc);
  const int vb0 = (int)(uintptr_t)V_lds + v_rd_base(lane);
  struct { bf16x8 vs0, vs1, ks0, ks1; } sr_[SDEPTH];
#define SLOAD(i, k0) do { sr_[i].vs0 = *reinterpret_cast<const bf16x8*>(&Vh[(long)((k0) + sr) * LDK + sc]); sr_[i].vs1 = *reinterpret_cast<const bf16x8*>(&Vh[(long)((k0) + 32 + sr) * LDK + sc]); \
    sr_[i].ks0 = *reinterpret_cast<const bf16x8*>(&Kh[(long)((k0) + sr) * LDK + sc]); sr_[i].ks1 = *reinterpret_cast<const bf16x8*>(&Kh[(long)((k0) + 32 + sr) * LDK + sc]); } while (0)
#define SWRITE(b, i) do { *(bf16x8*)((char*)V_lds + (b) * SHM_V + vst0) = sr_[i].vs0;          \
    *(bf16x8*)((char*)V_lds + (b) * SHM_V + vst1) = sr_[i].vs1; int kc = sc * 2;               \
    *(bf16x8*)((char*)K_lds + (b) * SHM_K + KSWZ(sr, kc)) = sr_[i].ks0;                       \
    *(bf16x8*)((char*)K_lds + (b) * SHM_K + KSWZ(32 + sr, kc)) = sr_[i].ks1; } while (0)
#define SWAIT() do { asm volatile("s_waitcnt vmcnt(4)" ::: "memory"); } while (0)
#define RESC(a) do { if (__any((a) < 1.f)) { if (hi == 0) al_l[r32] = (a); asm volatile("s_waitcnt lgkmcnt(0)" ::: "memory"); \
    for (int d = 0; d < 4; ++d) for (int r = 0; r < 16; ++r) o[d][r] *= al_l[crow(r, hi)]; } } while (0)
  f32x16 pA0, pA1, pB0, pB1; float mnA, mnB, alA, alB; bf16x8 pa0, pa1, pa2, pa3; const int NT = seq / KVBLK;
  constexpr int SE = 0, SO = SDEPTH - 1;
  SLOAD(SE, 0); asm volatile("s_waitcnt vmcnt(0)" ::: "memory"); SWRITE(0, SE); __syncthreads();
  qkt(pA0, pA1, K_lds, qr, r32, hi); partialSM(pA0, pA1, m_reg, mnA, alA);
  SLOAD(SO, KVBLK); if (2 < NT) SLOAD(SE, 2 * KVBLK);
  SWAIT(); SWRITE(1, SO); __syncthreads();
  for (int j = 1; j + 1 < NT; j += 2) {
    SBAR(); qkt(pB0, pB1, (bf16*)((char*)K_lds + SHM_K), qr, r32, hi);
    finishSM(pA0, pA1, alA, l_reg, pa0, pa1, pa2, pa3); SBAR();
    SLOAD(SO, (j + SDEPTH) * KVBLK); SBAR();
    pv_d0(o, vb0, pa0, pa1, pa2, pa3); partialSM(pB0, pB1, m_reg, mnB, alB);
    __syncthreads(); SWAIT(); SWRITE(0, SE);
    RESC(alB); __syncthreads();
    SBAR(); qkt(pA0, pA1, K_lds, qr, r32, hi);
    finishSM(pB0, pB1, alB, l_reg, pa0, pa1, pa2, pa3); SBAR();
    if (j + 3 < NT) SLOAD(SE, (j + 1 + SDEPTH) * KVBLK); SBAR();
    pv_d0(o, vb0 + (int)SHM_V, pa0, pa1, pa2, pa3); partialSM(pA0, pA1, m_reg, mnA, alA);
    __syncthreads(); SWAIT(); SWRITE(1, SO);
    RESC(alA); __syncthreads();
  }
  SBAR(); qkt(pB0, pB1, (bf16*)((char*)K_lds + SHM_K), qr, r32, hi);
  finishSM(pA0, pA1, alA, l_reg, pa0, pa1, pa2, pa3); SBAR();
  pv_d0(o, vb0, pa0, pa1, pa2, pa3); partialSM(pB0, pB1, m_reg, mnB, alB);
  __syncthreads(); RESC(alB);
  finishSM(pB0, pB1, alB, l_reg, pa0, pa1, pa2, pa3); SBAR();
  pv_d0(o, vb0 + (int)SHM_V, pa0, pa1, pa2, pa3);
  if (hi == 0) li_l[r32] = l_reg; asm volatile("s_waitcnt lgkmcnt(0)" ::: "memory");
  float rli[16];
#pragma unroll
  for (int r = 0; r < 16; ++r) rli[r] = __builtin_amdgcn_rcpf(li_l[crow(r, hi)]);
  bf16* Ow = Ob + (long)(wid * QBLK) * LDO;
#pragma unroll
  for (int r = 0; r < 16; ++r) { int orow = crow(r, hi);
    for (int d0 = 0; d0 < 4; ++d0) Ow[(long)orow * LDO + d0 * 32 + r32] = __float2bfloat16(o[d0][r] * rli[r]); }
#undef SLOAD
#undef SWRITE
#undef SWAIT
#undef RESC
}
#undef KSWZ
#undef SBAR
}
#define LAS __attribute__((address_space(3)))
typedef unsigned short bfu;
typedef short bf16x8 __attribute__((ext_vector_type(8)));
typedef float f32x4 __attribute__((ext_vector_type(4)));
typedef unsigned u32x4v __attribute__((ext_vector_type(4)));
typedef unsigned u32x2v __attribute__((ext_vector_type(2)));
using pg8::DM; using pg8::NBATCH; using pg8::SEQ; using pg8::CTXL; using pg8::RPB; using pg8::MR; using pg8::MH; using pg8::TPB; using pg8::HTILES; using pg8::FFD; using pg8::NMODW;
using pg8::bf2f; using pg8::cvt_pk_bf16; using pg8::fast_silu;
constexpr int NWAVES = 8, NTHR = 512, DEPTH = 4;
constexpr float EPS = 1e-6f;
constexpr int LDS_BYTES = 147456, LDS_CTL_OFF = 131072 + 64;
constexpr size_t al256(size_t x) { return (x + 255) / 256 * 256; }
constexpr size_t WS_BAR = 0, WS_BAR_BYTES = 16384;
constexpr size_t WS_MODS = WS_BAR_BYTES;
constexpr size_t WS_COSR = al256(WS_MODS + (size_t)DEPTH * 9 * NMODW * 4);
constexpr size_t WS_SINR = WS_COSR + (size_t)SEQ * 128 * 4;
constexpr size_t WS_COSRT = WS_SINR + (size_t)SEQ * 128 * 4;
constexpr size_t WS_SINRT = WS_COSRT + (size_t)SEQ * 128 * 4;
constexpr size_t WS_COSA = WS_SINRT + (size_t)SEQ * 128 * 4;
constexpr size_t WS_SINA = WS_COSA + (size_t)SEQ * 64 * 4;
constexpr size_t WS_X = WS_SINA + (size_t)SEQ * 64 * 4;
constexpr size_t WS_XN = WS_X + (size_t)MR * DM * 4;
constexpr size_t WS_W1A = WS_XN + (size_t)MR * DM * 2;
constexpr size_t WS_W2A = WS_W1A + (size_t)2 * FFD * DM * 2;
constexpr size_t WS_W1B = WS_W2A + (size_t)FFD * DM * 2;
constexpr size_t WS_W2B = WS_W1B + (size_t)2 * FFD * DM * 2;
constexpr size_t WS_WMIX = WS_W2B + (size_t)FFD * DM * 2;
constexpr size_t WMIX_QKG = 0, WMIX_KV = (size_t)4096 * DM * 2, WMIX_OUT = WMIX_KV + (size_t)3072 * DM * 2, WMIX_END = WMIX_OUT + (size_t)DM * 2048 * 2;
constexpr size_t WMIX_AQKV = 0, WMIX_AO = (size_t)1536 * DM * 2;
constexpr size_t WS_BIG = WS_WMIX + WMIX_END;
constexpr size_t BIG_QKG = 0, BIG_KVT = (size_t)MH * 4096 * 2, BIG_OF = BIG_KVT + (size_t)3072 * MH * 2, BIG_OB = BIG_OF + (size_t)MH * 2048 * 2, BIG_SP = BIG_OB + (size_t)MH * 2048 * 2,
                 BIG_RET_END = BIG_SP + (size_t)544 * 128 * 128 * 2;
constexpr size_t BIG_AQKV = 0, BIG_AO = (size_t)MR * 1536 * 2;
constexpr size_t BIG_H_END = (size_t)MR * FFD * 2;
constexpr size_t BIG_PART = (size_t)200 * 1048576, PART_KS = 11;
static_assert(BIG_PART >= BIG_H_END && BIG_PART + PART_KS * (size_t)NBATCH * CTXL * DM * 4 <= BIG_RET_END, "partial slabs inside BIG");
constexpr size_t WS_END = WS_BIG + (BIG_RET_END > BIG_H_END ? BIG_RET_END : BIG_H_END);

struct Args {
    const float *x, *c, *ctx, *c_ctx, *ada_w, *ada_b, *norm_g, *ffn_w1, *ffn_w2, *ret_w_in, *ret_w_out, *ret_dec_f, *ret_dec_b, *att_w_qkv, *att_w_o, *att_qg, *att_kg, *final_g;
    float* out; unsigned char* ws;
};

__device__ __forceinline__ float wave_sum(float v) {
#pragma unroll
    for (int o = 1; o < 64; o <<= 1) v += __shfl_xor(v, o);
    return v;
}
__device__ __forceinline__ unsigned f2bf(float f) { unsigned u = __builtin_bit_cast(unsigned, f); return (u + 0x7fffu + ((u >> 16) & 1u)) >> 16; }
__device__ __forceinline__ unsigned pk2(float lo, float hi) { return f2bf(lo) | (f2bf(hi) << 16); }
#define XB_TMO      128
#define XB_XCNT(j)  (256  + 64 * (j))
#define XB_XSUB(j)  (1280 + 64 * (j))
#define XB_XGEN(j)  (2304 + 64 * (j))
#define XB_TOP      3328
#define XB_TOPGEN   3392
#define XCD_BAR_WORDS 3456
#define XB_SPIN_CAP (1u << 18)

__device__ __forceinline__ unsigned xb_ld(unsigned* p)              { return __hip_atomic_load(p, __ATOMIC_RELAXED, __HIP_MEMORY_SCOPE_AGENT); }
__device__ __forceinline__ unsigned xb_add(unsigned* p, unsigned v) { return __hip_atomic_fetch_add(p, v, __ATOMIC_RELAXED, __HIP_MEMORY_SCOPE_AGENT); }
__device__ __forceinline__ unsigned xb_xcc_id() { return (unsigned)__builtin_amdgcn_s_getreg((3 << 11) | 20) & 0xFu; }
#define XB_SPIN(cond, bar) do { unsigned _sp = 0; while (cond) { __builtin_amdgcn_s_sleep(1); \
    if ((++_sp & 255u) == 0u) { if (xb_ld(&(bar)[XB_TMO])) break; if (_sp > XB_SPIN_CAP) { atomicAdd(&(bar)[XB_TMO], 1u); break; } } } } while (0)

struct XcdBarrier {
    unsigned* bar; unsigned x;
    volatile LAS unsigned* st;
};

__device__ __forceinline__ XcdBarrier xcd_barrier_post(unsigned* bar, volatile LAS unsigned* st) {
    XcdBarrier b; b.bar = bar; b.x = xb_xcc_id(); b.st = st;
    if (otid() == 0) (void)xb_add(&bar[XB_XCNT(b.x)], 1u);
    return b;
}
__device__ __forceinline__ void xcd_barrier_complete(unsigned* bar, unsigned x, unsigned& nloc, unsigned& nx) {
    const unsigned G = (unsigned)ogrid();
    unsigned sum, cnt, mine, sp = 0u;
    for (;;) {
        sum = 0u; cnt = 0u; mine = 0u;
#pragma unroll
        for (unsigned j = 0; j < 16; ++j) { const unsigned c = xb_ld(&bar[XB_XCNT(j)]); sum += c; cnt += (c > 0u) ? 1u : 0u; mine = (j == x) ? c : mine; }
        if (sum == G) break;
        __builtin_amdgcn_s_sleep(1);
        if ((++sp & 255u) == 0u) { if (xb_ld(&bar[XB_TMO])) break; if (sp > XB_SPIN_CAP) { atomicAdd(&bar[XB_TMO], 1u); break; } }
    }
    nloc = mine > 0u ? mine : 1u; nx = cnt > 0u ? cnt : 1u;
}

__device__ __forceinline__ void xcd_barrier(const XcdBarrier& b) {
    asm volatile("s_waitcnt vmcnt(0)" ::: "memory");
    __syncthreads();
    if (otid() == 0) {
        unsigned* bar = b.bar;
        __builtin_amdgcn_s_waitcnt(0);
        unsigned nloc = b.st[0], nx = b.st[1];
        if (nloc == 0u) { xcd_barrier_complete(bar, b.x, nloc, nx); b.st[0] = nloc; b.st[1] = nx; }
        const unsigned old = xb_add(&bar[XB_XSUB(b.x)], 1u);
        const unsigned gen = old / nloc;
        if (old + 1u == (gen + 1u) * nloc) {
            __builtin_amdgcn_fence(__ATOMIC_RELEASE, "agent");
            asm volatile("s_waitcnt vmcnt(0)" ::: "memory");
            const unsigned og = xb_add(&bar[XB_TOP], 1u);
            const unsigned tg = og / nx;
            if (og + 1u == (tg + 1u) * nx) xb_add(&bar[XB_TOPGEN], 1u);
            else XB_SPIN(xb_ld(&bar[XB_TOPGEN]) == tg, bar);
            __builtin_amdgcn_fence(__ATOMIC_ACQUIRE, "agent");
            xb_add(&bar[XB_XGEN(b.x)], 1u);
            asm volatile("s_waitcnt vmcnt(0)" ::: "memory");
        } else {
            XB_SPIN(xb_ld(&bar[XB_XGEN(b.x)]) == gen, bar);
            __builtin_amdgcn_fence(__ATOMIC_ACQUIRE, "agent");
            asm volatile("s_waitcnt vmcnt(0)" ::: "memory");
        }
    }
    __syncthreads();
}


__device__ __forceinline__ void transpose_item(const float* W, int K, int N, bfu* WT, int k0, int n0, int drow, float scale, LAS float* scr, int lane) {
#pragma unroll 8
    for (int i = 0; i < 32; ++i) { const int kk = 2 * i + (lane >> 5); scr[kk * 33 + (lane & 31)] = W[(size_t)(k0 + kk) * N + n0 + (lane & 31)] * scale; }
    asm volatile("s_waitcnt lgkmcnt(0)" ::: "memory");
    const int c = lane & 7;
#pragma unroll
    for (int j = 0; j < 4; ++j) { const int n = (lane >> 3) + 8 * j; const LAS float* s = scr + (8 * c) * 33 + n;
        u32x4v o; o.x = pk2(s[0 * 33], s[1 * 33]); o.y = pk2(s[2 * 33], s[3 * 33]); o.z = pk2(s[4 * 33], s[5 * 33]); o.w = pk2(s[6 * 33], s[7 * 33]);
        *(u32x4v*)(WT + (size_t)(drow + n) * K + k0 + 8 * c) = o; }
    asm volatile("s_waitcnt lgkmcnt(0)" ::: "memory");
}
__device__ __forceinline__ void conv_job(const float* W, int K, int N, int c0, int cnt, bfu* WT, int drow0, float scale, int mode, LAS float* scr, int lane, int gw, int NGW) {
    const int nblk = cnt / 32, nitems = (K / 64) * nblk;
    for (int it = gw; it < nitems; it += NGW) {
        const int kb = it / nblk, nb = it - kb * nblk; const int col = c0 + 32 * nb; int drow;
        if (mode == 0) drow = drow0 + 32 * nb;
        else { const int up = col >= FFD, j = up ? col - FFD : col; drow = 256 * (j >> 7) + (up ? 128 : 0) + (j & 127); }
        transpose_item(W, K, N, WT, 64 * kb, col, drow, scale, scr, lane);
    }
}
#define MFMA16(a, b, c) __builtin_amdgcn_mfma_f32_16x16x32_bf16((a), (b), (c), 0, 0, 0)

__device__ __forceinline__ void phase_ada_rope(const Args& a, unsigned char* ws, LAS unsigned char* lds) {
    const int tid = otid(), lane = tid & 63, wave = tid >> 6;
    LAS float* scs = (LAS float*)lds;
    LAS float* part = (LAS float*)(lds + 9 * 1024 * 4);
    for (int i = tid; i < 9 * 1024; i += NTHR) { const float v = (i < 8 * 1024) ? a.c[i] : a.c_ctx[i - 8 * 1024]; scs[i] = v / (1.0f + expf(-v)); }
    __syncthreads();
    float* mods = (float*)(ws + WS_MODS);
    for (int it = obid(); it < DEPTH * 144; it += ogrid()) {
        const int l = it / 144, cg0 = (it - l * 144) * 64, col = cg0 + lane;
        const float* wp = a.ada_w + ((size_t)l * DM + wave * 128) * NMODW + col;
        float acc[9];
#pragma unroll
        for (int r = 0; r < 9; ++r) acc[r] = 0.f;
        for (int k = 0; k < 128; k += 16) {
            float wv[16];
#pragma unroll
            for (int i = 0; i < 16; ++i) wv[i] = wp[(size_t)(k + i) * NMODW];
#pragma unroll
            for (int q = 0; q < 4; ++q)
#pragma unroll
                for (int r = 0; r < 9; ++r) { const f32x4 s = *(const LAS f32x4*)(scs + r * 1024 + wave * 128 + k + 4 * q); acc[r] += s[0] * wv[4 * q] + s[1] * wv[4 * q + 1] + s[2] * wv[4 * q + 2] + s[3] * wv[4 * q + 3]; }
        }
#pragma unroll
        for (int r = 0; r < 9; ++r) part[(wave * 9 + r) * 64 + lane] = acc[r];
        __syncthreads();
        for (int o = tid; o < 9 * 64; o += NTHR) { const int r = o >> 6, cc = o & 63; float s = 0.f;
#pragma unroll
            for (int w = 0; w < 8; ++w) s += part[(w * 9 + r) * 64 + cc];
            mods[((size_t)l * 9 + r) * NMODW + cg0 + cc] = s + a.ada_b[(size_t)l * NMODW + cg0 + cc]; }
        __syncthreads();
    }
    float* cosR = (float*)(ws + WS_COSR); float* sinR = (float*)(ws + WS_SINR); float* cosRT = (float*)(ws + WS_COSRT); float* sinRT = (float*)(ws + WS_SINRT);
    float* cosA = (float*)(ws + WS_COSA); float* sinA = (float*)(ws + WS_SINA);
    const int gt = obid() * NTHR + tid, NT = ogrid() * NTHR;
    const double TWO_PI = 6.283185307179586476925286766559, L2T = 13.287712379549449391481277717958;
    for (int i = gt; i < SEQ * 128; i += NT) { const int pos = i >> 7, j = i & 127;
        const double fr = exp2(-(double)j * (1.0 / 128.0) * L2T); double ang = (double)pos * fr; ang -= TWO_PI * rint(ang / TWO_PI);
        const float cs = cosf((float)ang), sn = sinf((float)ang);
        cosR[i] = cs; sinR[i] = sn; cosRT[(size_t)j * SEQ + pos] = cs; sinRT[(size_t)j * SEQ + pos] = sn; }
    for (int i = gt; i < SEQ * 64; i += NT) { const int pos = i >> 6, jj = i & 63;
        const double fr = exp2(-(double)(jj & 31) * (1.0 / 32.0) * L2T); const int pv = (jj < 32) ? (pos >> 6) : (pos & 63);
        double ang = (double)pv * fr; ang -= TWO_PI * rint(ang / TWO_PI);
        cosA[i] = cosf((float)ang); sinA[i] = sinf((float)ang); }
}

__device__ __forceinline__ void phase_conv_weights(const Args& a, unsigned char* ws, LAS unsigned char* lds, int L) {
    const int tid = otid(), lane = tid & 63, wave = tid >> 6; const int gw = obid() * NWAVES + wave, NGW = ogrid() * NWAVES;
    LAS float* scr = (LAS float*)(lds + wave * 16384);
    const float* w1 = a.ffn_w1 + (size_t)L * 2 * DM * 2 * FFD; const float* w2 = a.ffn_w2 + (size_t)L * 2 * FFD * DM;
    conv_job(w1, DM, 2 * FFD, 0, 2 * FFD, (bfu*)(ws + WS_W1A), 0, 1.f, 1, scr, lane, gw, NGW);
    conv_job(w1 + (size_t)DM * 2 * FFD, DM, 2 * FFD, 0, 2 * FFD, (bfu*)(ws + WS_W1B), 0, 1.f, 1, scr, lane, gw, NGW);
    conv_job(w2, FFD, DM, 0, DM, (bfu*)(ws + WS_W2A), 0, 1.f, 0, scr, lane, gw, NGW);
    conv_job(w2 + (size_t)FFD * DM, FFD, DM, 0, DM, (bfu*)(ws + WS_W2B), 0, 1.f, 0, scr, lane, gw, NGW);
    const int j = L >> 1;
    if ((L & 1) == 0) {
        const float* win = a.ret_w_in + (size_t)j * DM * 6144; const float* wout = a.ret_w_out + (size_t)j * 2048 * DM;
        bfu* qkg = (bfu*)(ws + WS_WMIX + WMIX_QKG); bfu* kv = (bfu*)(ws + WS_WMIX + WMIX_KV);
        conv_job(win, DM, 6144, 0, 1024, qkg, 0, 1.f, 0, scr, lane, gw, NGW);
        conv_job(win, DM, 6144, 1024, 1024, qkg, 1024, 0.0625f, 0, scr, lane, gw, NGW);
        conv_job(win, DM, 6144, 4096, 2048, qkg, 2048, 1.f, 0, scr, lane, gw, NGW);
        conv_job(win, DM, 6144, 1024, 1024, kv, 0, 0.0625f, 0, scr, lane, gw, NGW);
        conv_job(win, DM, 6144, 2048, 2048, kv, 1024, 1.f, 0, scr, lane, gw, NGW);
        conv_job(wout, 2048, DM, 0, DM, (bfu*)(ws + WS_WMIX + WMIX_OUT), 0, 1.f, 0, scr, lane, gw, NGW);
    } else {
        conv_job(a.att_w_qkv + (size_t)j * DM * 1536, DM, 1536, 0, 1536, (bfu*)(ws + WS_WMIX + WMIX_AQKV), 0, 1.f, 0, scr, lane, gw, NGW);
        conv_job(a.att_w_o + (size_t)j * DM * DM, DM, DM, 0, DM, (bfu*)(ws + WS_WMIX + WMIX_AO), 0, 1.f, 0, scr, lane, gw, NGW);
    }
}

__device__ __forceinline__ void phase_modnorm(const Args& a, unsigned char* ws, int L, int idx, bool first, int pend) {
    const int tid = otid(), lane = tid & 63, wave = tid >> 6; const int gw = obid() * NWAVES + wave, NGW = ogrid() * NWAVES;
    const float* mods = (const float*)(ws + WS_MODS) + (size_t)L * 9 * NMODW; const float* ng = a.norm_g + (size_t)(L * 3 + idx) * DM;
    float* X = (float*)(ws + WS_X); bfu* XN = (bfu*)(ws + WS_XN);
    for (int r = gw; r < MR; r += NGW) {
        const int b = r / RPB, t = r - b * RPB; const int mrow = (t >= SEQ) ? 8 : b;
        const float* src = first ? ((t < SEQ) ? a.x + ((size_t)b * SEQ + t) * DM : a.ctx + ((size_t)b * CTXL + (t - SEQ)) * DM) : X + (size_t)r * DM;
        f32x4 v[4]; float s = 0.f;
#pragma unroll
        for (int j = 0; j < 4; ++j) { v[j] = ((const f32x4*)src)[lane + 64 * j]; s += (v[j][0] * v[j][0] + v[j][1] * v[j][1]) + (v[j][2] * v[j][2] + v[j][3] * v[j][3]); }
        if (pend && t >= SEQ) {
            const float* gt = (const float*)(ws + WS_MODS) + (size_t)(pend == 1 ? L : L - 1) * 9 * NMODW + (size_t)8 * NMODW + (pend == 1 ? 2 : 8) * DM;
            const float* P = (const float*)(ws + WS_BIG + BIG_PART) + (size_t)(b * CTXL + (t - SEQ)) * DM; s = 0.f;
#pragma unroll
            for (int j = 0; j < 4; ++j) { f32x4 acc = (f32x4){0.f, 0.f, 0.f, 0.f};
#pragma unroll
                for (int ks = 0; ks < (int)PART_KS; ++ks) acc = acc + ((const f32x4*)(P + (size_t)ks * NBATCH * CTXL * DM))[lane + 64 * j];
                const f32x4 g4 = *(const f32x4*)(gt + 4 * lane + 256 * j);
                v[j] = v[j] + (g4 * 0.5f) * acc; s += (v[j][0] * v[j][0] + v[j][1] * v[j][1]) + (v[j][2] * v[j][2] + v[j][3] * v[j][3]); }
        }
        if (first || (pend && t >= SEQ)) {
#pragma unroll
            for (int j = 0; j < 4; ++j) ((f32x4*)(X + (size_t)r * DM))[lane + 64 * j] = v[j];
        }
        const float rstd = rsqrtf(wave_sum(s) * (1.0f / DM) + EPS);
        const float* sh = mods + (size_t)mrow * NMODW + (3 * idx) * DM; const float* sc = sh + DM;
#pragma unroll
        for (int j = 0; j < 4; ++j) { const int col = 4 * lane + 256 * j;
            const f32x4 g4 = *(const f32x4*)(ng + col), s4 = *(const f32x4*)(sc + col), h4 = *(const f32x4*)(sh + col);
            const f32x4 y = (v[j] * rstd) * g4 * (s4 + 1.0f) + h4;
            u32x2v w; w.x = pk2(y[0], y[1]); w.y = pk2(y[2], y[3]); *(u32x2v*)(XN + (size_t)r * DM + col) = w; }
    }
}
__device__ __forceinline__ void phase_final(const Args& a, unsigned char* ws) {
    const int tid = otid(), lane = tid & 63, wave = tid >> 6; const int gw = obid() * NWAVES + wave, NGW = ogrid() * NWAVES;
    const float* X = (const float*)(ws + WS_X);
    for (int q = gw; q < NBATCH * SEQ; q += NGW) {
        const int b = q / SEQ, t = q - b * SEQ; const float* src = X + ((size_t)b * RPB + t) * DM;
        f32x4 v[4]; float s = 0.f;
#pragma unroll
        for (int j = 0; j < 4; ++j) { v[j] = ((const f32x4*)src)[lane + 64 * j]; s += (v[j][0] * v[j][0] + v[j][1] * v[j][1]) + (v[j][2] * v[j][2] + v[j][3] * v[j][3]); }
        const float rstd = rsqrtf(wave_sum(s) * (1.0f / DM) + EPS);
#pragma unroll
        for (int j = 0; j < 4; ++j) { const int col = 4 * lane + 256 * j; const f32x4 g4 = *(const f32x4*)(a.final_g + col);
            *(f32x4*)(a.out + (size_t)q * DM + col) = (v[j] * rstd) * g4; }
    }
}

__device__ __forceinline__ void phase_qknorm(const Args& a, unsigned char* ws, int j) {
    const int tid = otid(), lane = tid & 63, wave = tid >> 6; const int gw = obid() * NWAVES + wave, NGW = ogrid() * NWAVES;
    bfu* QKV = (bfu*)(ws + WS_BIG + BIG_AQKV); const float* cosA = (const float*)(ws + WS_COSA); const float* sinA = (const float*)(ws + WS_SINA);
    const int sub = lane & 15;
    for (int it = gw * 4 + (lane >> 4); it < MR * 10; it += NGW * 4) {
        const int r = it / 10, hh = it - r * 10; const int b = r / RPB, t = r - b * RPB;
        bfu* p = QKV + (size_t)r * 1536 + hh * 128 + 8 * sub;
        const bf16x8 raw = *(const bf16x8*)p; float x[8]; float ss = 0.f;
#pragma unroll
        for (int i = 0; i < 8; ++i) { x[i] = bf2f((unsigned short)raw[i]); ss += x[i] * x[i]; }
        ss += __shfl_xor(ss, 1); ss += __shfl_xor(ss, 2); ss += __shfl_xor(ss, 4); ss += __shfl_xor(ss, 8);
        const float rstd = rsqrtf(ss * (1.0f / 128.0f) + EPS);
        const float* gn = ((hh < 8) ? a.att_qg : a.att_kg) + (size_t)j * 128 + 8 * sub;
#pragma unroll
        for (int i = 0; i < 8; ++i) x[i] = x[i] * rstd * gn[i];
        const bool lat = t < SEQ; const int jj = 8 * (sub & 7); const int tt = lat ? t : 0;
#pragma unroll
        for (int i = 0; i < 8; ++i) { const float other = __shfl_xor(x[i], 8); const float cs = cosA[(size_t)tt * 64 + jj + i], sn = sinA[(size_t)tt * 64 + jj + i];
            const float rot = (sub < 8) ? (x[i] * cs - other * sn) : (x[i] * cs + other * sn); x[i] = lat ? rot : x[i]; }
        u32x4v w; w.x = pk2(x[0], x[1]); w.y = pk2(x[2], x[3]); w.z = pk2(x[4], x[5]); w.w = pk2(x[6], x[7]);
        *(u32x4v*)p = w;
    }
}
__device__ __forceinline__ void phase_attention(unsigned char* ws, char* lds) {
    const attn::bf16* QKV = (const attn::bf16*)(ws + WS_BIG + BIG_AQKV); attn::bf16* AO = (attn::bf16*)(ws + WS_BIG + BIG_AO);
    for (int u = obid(); u < 1024 + 64; u += ogrid()) {
        int b, h, row0, key0, seq;
        if (u < 1024) { const int qb = u & 15; h = (u >> 4) & 7; b = u >> 7; row0 = b * RPB + qb * 256; key0 = b * RPB; seq = RPB; }
        else { const int v = u - 1024; h = v & 7; b = v >> 3; row0 = b * RPB + SEQ; key0 = b * RPB + SEQ; seq = CTXL; }
        const int kvh = h >> 2;
        attn::attn_dense_body(QKV + (size_t)row0 * 1536 + h * 128, QKV + (size_t)key0 * 1536 + 1024 + kvh * 128, QKV + (size_t)key0 * 1536 + 1280 + kvh * 128,
                              AO + (size_t)row0 * 1024 + h * 128, seq, lds);
        __syncthreads();
    }
}

__device__ __forceinline__ int ret_tok0(int bl, int cidx) { return bl * RPB + ((cidx < 32) ? 128 * cidx : SEQ + 128 * (cidx - 32)); }
__device__ __forceinline__ void phase_ret_sprime(const Args& a, unsigned char* ws, int j) {
    const int tid = otid(), lane = tid & 63, w = tid >> 6, r16 = lane & 15, quad = lane >> 4;
    const bfu* QKG = (const bfu*)(ws + WS_BIG + BIG_QKG); bfu* SP = (bfu*)(ws + WS_BIG + BIG_SP);
    for (int it = obid(); it < 544; it += ogrid()) {
        const int bh = it / 34, cidx = it - bh * 34, bl = bh >> 2, h = bh & 3; const int tok0 = ret_tok0(bl, cidx);
        const float l2f = -expf(a.ret_dec_f[j * 4 + h]) * 1.4426950408889634f, l2b = -expf(a.ret_dec_b[j * 4 + h]) * 1.4426950408889634f;
        const bfu* qp = QKG + (size_t)(tok0 + 16 * w + r16) * 4096 + 256 * h + 8 * quad;
        const bfu* kp = QKG + (size_t)(tok0 + r16) * 4096 + 1024 + 256 * h + 8 * quad;
        f32x4 acc[8];
#pragma unroll
        for (int mb = 0; mb < 8; ++mb) acc[mb] = (f32x4){0.f, 0.f, 0.f, 0.f};
#pragma unroll 2
        for (int ks = 0; ks < 8; ++ks) {
            const bf16x8 bq = *(const bf16x8*)(qp + 32 * ks);
#pragma unroll
            for (int mb = 0; mb < 8; ++mb) { const bf16x8 ak = *(const bf16x8*)(kp + (size_t)(16 * mb) * 4096 + 32 * ks); acc[mb] = MFMA16(ak, bq, acc[mb]); }
        }
        const int c = 16 * w + r16;
#pragma unroll
        for (int mb = 0; mb < 8; ++mb) { float v[4];
#pragma unroll
            for (int jj = 0; jj < 4; ++jj) { const int m = 16 * mb + 4 * quad + jj; const int d = c - m;
                const float mk = (d > 0) ? __builtin_amdgcn_exp2f((float)d * l2f) : ((d < 0) ? __builtin_amdgcn_exp2f((float)(-d) * l2b) : 2.0f); v[jj] = acc[mb][jj] * mk; }
            u32x2v o; o.x = cvt_pk_bf16(v[0], v[1]); o.y = cvt_pk_bf16(v[2], v[3]);
            *(u32x2v*)(SP + ((size_t)it * 128 + c) * 128 + 16 * mb + 4 * quad) = o; }
    }
}
constexpr int SROW = 264, KROW = 264, VROW = 136;
__device__ __forceinline__ int scan_cidx(int s, int dir) { return (s < 2) ? (dir ? (33 - s) : (32 + s)) : (dir ? (33 - s) : (s - 2)); }
__device__ __forceinline__ void phase_ret_scan(const Args& a, unsigned char* ws, LAS unsigned char* lds, int j) {
    const int tid = otid(), lane = tid & 63, w = tid >> 6, r16 = lane & 15, quad = lane >> 4;
    const bfu* QKG = (const bfu*)(ws + WS_BIG + BIG_QKG); const bfu* KVT = (const bfu*)(ws + WS_BIG + BIG_KVT);
    LAS bfu* SL = (LAS bfu*)lds; LAS bfu* KB = SL + 64 * SROW; LAS bfu* VB = KB + 64 * KROW;
    for (int it = obid(); it < 256; it += ogrid()) {
        const int es = it & 7, dir = (it >> 3) & 1, h = (it >> 4) & 3, bl = it >> 6;
        bfu* OD = (bfu*)(ws + WS_BIG + (dir ? BIG_OB : BIG_OF));
        const float l2f = -expf(a.ret_dec_f[j * 4 + h]) * 1.4426950408889634f, l2b = -expf(a.ret_dec_b[j * 4 + h]) * 1.4426950408889634f;
        const float l2g = dir ? l2b : l2f;
        const float gC = __builtin_amdgcn_exp2f(128.0f * l2g);
        const int cl = 16 * w + r16;
        const float xi = __builtin_amdgcn_exp2f((dir ? (float)(128 - cl) : (float)(cl + 1)) * l2g);
        float rp[8];
#pragma unroll
        for (int i = 0; i < 8; ++i) rp[i] = __builtin_amdgcn_exp2f((dir ? (float)i : (float)(-i)) * l2g);
        f32x4 st[4][2];
#pragma unroll
        for (int eb = 0; eb < 4; ++eb) { st[eb][0] = (f32x4){0.f, 0.f, 0.f, 0.f}; st[eb][1] = (f32x4){0.f, 0.f, 0.f, 0.f}; }
        for (int i = tid; i < 64 * SROW; i += NTHR) SL[i] = 0;
        const bfu* gkb = QKG + (size_t)(64 * dir + (tid >> 5)) * 4096 + 1024 + 256 * h + (tid & 31) * 8;
        const bfu* gvb = KVT + (size_t)(1024 + 512 * h + 64 * es + (tid >> 4)) * MH + (tid & 15) * 8;
        LAS bfu* kst = KB + (tid >> 5) * KROW + (tid & 31) * 8;  LAS bfu* vst = VB + (tid >> 4) * VROW + (tid & 15) * 8;
        const bfu* qb_ = QKG + (size_t)cl * 4096 + 256 * h + 8 * quad;
        const bfu* kTb = KVT + (size_t)(256 * h + 32 * w + r16) * MH + 8 * quad;
        bf16x8 bq[8], kr[4][2], gk[4], gv[2];
        {   const int tok = ret_tok0(bl, scan_cidx(0, dir));
#pragma unroll
            for (int p = 0; p < 4; ++p) gk[p] = *(const bf16x8*)(gkb + (size_t)(tok + 16 * p) * 4096);
#pragma unroll
            for (int p = 0; p < 2; ++p) gv[p] = *(const bf16x8*)(gvb + (size_t)(32 * p) * MH + tok);
#pragma unroll
            for (int ks = 0; ks < 8; ++ks) bq[ks] = *(const bf16x8*)(qb_ + (size_t)tok * 4096 + 32 * ks);
#pragma unroll
            for (int p = 0; p < 4; ++p) *(LAS bf16x8*)(kst + 16 * p * KROW) = gk[p];
#pragma unroll
            for (int p = 0; p < 2; ++p) *(LAS bf16x8*)(vst + 32 * p * VROW) = gv[p];
        }
        __syncthreads();
#pragma unroll 1
        for (int s = 0; s < 34; ++s) {
            const int tok0 = ret_tok0(bl, scan_cidx(s, dir)); const int tokn = ret_tok0(bl, scan_cidx(s < 33 ? s + 1 : s, dir));
#pragma unroll
            for (int ks = 0; ks < 4; ++ks) { kr[ks][0] = *(const bf16x8*)(kTb + tok0 + 32 * ks); kr[ks][1] = *(const bf16x8*)(kTb + (size_t)16 * MH + tok0 + 32 * ks); }
            f32x4 oa[4], sa[4];
#pragma unroll
            for (int eb = 0; eb < 4; ++eb) { oa[eb] = (f32x4){0.f, 0.f, 0.f, 0.f}; sa[eb] = (f32x4){0.f, 0.f, 0.f, 0.f}; }
            const LAS bfu* sl = SL + r16 * SROW + 8 * quad; const LAS bfu* kl = KB + r16 * KROW + 8 * quad; const LAS bfu* vl = VB + r16 * VROW;
#pragma unroll
            for (int ks = 0; ks < 8; ++ks) { bf16x8 fa[4], fk[4];
#pragma unroll
                for (int eb = 0; eb < 4; ++eb) { fa[eb] = *(const LAS bf16x8*)(sl + 16 * eb * SROW + 32 * ks); fk[eb] = *(const LAS bf16x8*)(kl + 16 * eb * KROW + 32 * ks); }
#pragma unroll
                for (int eb = 0; eb < 4; ++eb) { oa[eb] = MFMA16(fa[eb], bq[ks], oa[eb]); sa[eb] = MFMA16(fk[eb], bq[ks], sa[eb]); } }
#pragma unroll
            for (int ks = 0; ks < 8; ++ks) bq[ks] = *(const bf16x8*)(qb_ + (size_t)tokn * 4096 + 32 * ks);
#pragma unroll
            for (int p = 0; p < 4; ++p) gk[p] = *(const bf16x8*)(gkb + (size_t)(tokn + 16 * p) * 4096);
#pragma unroll
            for (int p = 0; p < 2; ++p) gv[p] = *(const bf16x8*)(gvb + (size_t)(32 * p) * MH + tokn);
#pragma unroll
            for (int eb = 0; eb < 4; ++eb) oa[eb] = oa[eb] * xi;
            unsigned sw2[4][2];
#pragma unroll
            for (int mb2 = 0; mb2 < 4; ++mb2) { float v[4];
#pragma unroll
                for (int jj = 0; jj < 4; ++jj) { const int m = 64 * dir + 16 * mb2 + 4 * quad + jj; const int d = cl - m;
                    const float mk = (d > 0) ? __builtin_amdgcn_exp2f((float)d * l2f) : ((d < 0) ? __builtin_amdgcn_exp2f((float)(-d) * l2b) : 2.0f); v[jj] = sa[mb2][jj] * mk; }
                sw2[mb2][0] = cvt_pk_bf16(v[0], v[1]); sw2[mb2][1] = cvt_pk_bf16(v[2], v[3]); }
#pragma unroll
            for (int kk = 0; kk < 2; ++kk) { u32x4v bw; bw.x = sw2[2 * kk][0]; bw.y = sw2[2 * kk][1]; bw.z = sw2[2 * kk + 1][0]; bw.w = sw2[2 * kk + 1][1];
                const bf16x8 bs = __builtin_bit_cast(bf16x8, bw);
#pragma unroll
                for (int eb = 0; eb < 4; ++eb) { const LAS bfu* vp = vl + 16 * eb * VROW + 64 * dir + 32 * kk + 4 * quad;
                    const u32x2v a0 = *(const LAS u32x2v*)vp, a1 = *(const LAS u32x2v*)(vp + 16);
                    u32x4v aw; aw.x = a0.x; aw.y = a0.y; aw.z = a1.x; aw.w = a1.y; oa[eb] = MFMA16(__builtin_bit_cast(bf16x8, aw), bs, oa[eb]); } }
            asm volatile("s_nop 15\n\ts_nop 7" : "+v"(oa[0]), "+v"(oa[1]), "+v"(oa[2]), "+v"(oa[3]));
            bfu* op = OD + (size_t)(tok0 + cl) * 2048 + 512 * h + 64 * es + 4 * quad;
#pragma unroll
            for (int eb = 0; eb < 4; ++eb) { u32x2v o; o.x = cvt_pk_bf16(oa[eb][0], oa[eb][1]); o.y = cvt_pk_bf16(oa[eb][2], oa[eb][3]); *(u32x2v*)(op + 16 * eb) = o; }
#pragma unroll
            for (int eb = 0; eb < 4; ++eb) { st[eb][0] = st[eb][0] * gC; st[eb][1] = st[eb][1] * gC; }
#pragma unroll
            for (int ks = 0; ks < 4; ++ks) { const int c0 = 32 * ks + 8 * quad;
                const float zb = __builtin_amdgcn_exp2f((dir ? (float)c0 : (float)(127 - c0)) * l2g);
                bf16x8 kz[2];
#pragma unroll
                for (int db = 0; db < 2; ++db) { float z[8];
#pragma unroll
                    for (int i = 0; i < 8; ++i) z[i] = bf2f((unsigned short)kr[ks][db][i]) * (zb * rp[i]);
                    u32x4v kw; kw.x = cvt_pk_bf16(z[0], z[1]); kw.y = cvt_pk_bf16(z[2], z[3]); kw.z = cvt_pk_bf16(z[4], z[5]); kw.w = cvt_pk_bf16(z[6], z[7]);
                    kz[db] = __builtin_bit_cast(bf16x8, kw); }
#pragma unroll
                for (int eb = 0; eb < 4; ++eb) { const bf16x8 vfr = *(const LAS bf16x8*)(vl + 16 * eb * VROW + 32 * ks + 8 * quad);
                    st[eb][0] = MFMA16(vfr, kz[0], st[eb][0]); st[eb][1] = MFMA16(vfr, kz[1], st[eb][1]); } }
            asm volatile("s_waitcnt lgkmcnt(0)" ::: "memory"); __builtin_amdgcn_s_barrier(); asm volatile("" ::: "memory");
#pragma unroll
            for (int eb = 0; eb < 4; ++eb)
#pragma unroll
                for (int db = 0; db < 2; ++db)
#pragma unroll
                    for (int jj = 0; jj < 4; ++jj) SL[(16 * eb + 4 * quad + jj) * SROW + 32 * w + 16 * db + r16] = (bfu)f2bf(st[eb][db][jj]);
#pragma unroll
            for (int p = 0; p < 4; ++p) *(LAS bf16x8*)(kst + 16 * p * KROW) = gk[p];
#pragma unroll
            for (int p = 0; p < 2; ++p) *(LAS bf16x8*)(vst + 32 * p * VROW) = gv[p];
            asm volatile("s_waitcnt lgkmcnt(0)" ::: "memory"); __builtin_amdgcn_s_barrier(); asm volatile("" ::: "memory");
        }
        __syncthreads();
    }
}
__device__ __forceinline__ void phase_ret_merge(unsigned char* ws) {
    const int tid = otid(), lane = tid & 63, wave = tid >> 6; const int gw = obid() * NWAVES + wave, NGW = ogrid() * NWAVES;
    bfu* OF = (bfu*)(ws + WS_BIG + BIG_OF); const bfu* OB = (const bfu*)(ws + WS_BIG + BIG_OB); const bfu* QKG = (const bfu*)(ws + WS_BIG + BIG_QKG);
    for (int it = gw; it < MH * 4; it += NGW) {
        const int r = it >> 2, h = it & 3; const size_t off = (size_t)r * 2048 + 512 * h + 8 * lane;
        const bf16x8 f = *(const bf16x8*)(OF + off), b = *(const bf16x8*)(OB + off), g = *(const bf16x8*)(QKG + (size_t)r * 4096 + 2048 + 512 * h + 8 * lane);
        float o[8]; float ss = 0.f;
#pragma unroll
        for (int i = 0; i < 8; ++i) { o[i] = bf2f((unsigned short)f[i]) + bf2f((unsigned short)b[i]); ss += o[i] * o[i]; }
        const float rstd = rsqrtf(wave_sum(ss) * (1.0f / 512.0f) + EPS);
#pragma unroll
        for (int i = 0; i < 8; ++i) o[i] = o[i] * rstd * bf2f((unsigned short)g[i]);
        u32x4v w; w.x = pk2(o[0], o[1]); w.y = pk2(o[2], o[3]); w.z = pk2(o[4], o[5]); w.w = pk2(o[6], o[7]);
        *(u32x4v*)(OF + off) = w;
    }
}
typedef const __attribute__((address_space(4))) Args* KArgs;
__device__ __forceinline__ Args kargs() {
#if defined(__HIP_DEVICE_COMPILE__)
    KArgs p = (KArgs)__builtin_amdgcn_kernarg_segment_ptr(); asm volatile("" : "+s"(p)); return *p;
#else
    return Args{};
#endif
}
#define KA() const Args a = kargs(); unsigned char* const ws = a.ws; (void)ws
__global__ void __launch_bounds__(NTHR, 2) fwd_kernel(Args a_unused) {
    extern __shared__ __attribute__((aligned(16))) unsigned char lds_raw[];
    cg::grid_group grid = cg::this_grid();
    LAS unsigned char* lds = (LAS unsigned char*)lds_raw;
#ifndef PHM
#define PHM 0xFFFFFFFFu
#endif
#define PH(n) if ((PHM >> (n)) & 1u)
#define GSYNC_CG() do { asm volatile("s_waitcnt vmcnt(0) lgkmcnt(0)" ::: "memory"); grid.sync(); asm volatile("" ::: "memory"); } while (0)
#define GSYNC() do { for (int rs_ = 0; rs_ < REP_SYNC; ++rs_) { KA(); XcdBarrier xb_; xb_.bar = (unsigned*)(ws + WS_BAR); xb_.x = xb_xcc_id(); xb_.st = (volatile LAS unsigned*)(lds + LDS_CTL_OFF); xcd_barrier(xb_); asm volatile("" ::: "memory"); } } while (0)
#ifndef REP_SCAN
#define REP_SCAN 1
#endif
#ifndef REP_ATT
#define REP_ATT 1
#endif
#ifndef REP_W1
#define REP_W1 1
#endif
#ifndef REP_MN
#define REP_MN 1
#endif
#ifndef REP_CONV
#define REP_CONV 1
#endif
#ifndef REP_INP
#define REP_INP 1
#endif
#ifndef REP_ADA
#define REP_ADA 1
#endif
#ifndef REP_W2
#define REP_W2 1
#endif
#ifndef REP_SYNC
#define REP_SYNC 1
#endif
#define XP ((float*)(ws + WS_X))
#define XNP ((const bfu*)(ws + WS_XN))
#define MODSL ((const float*)(ws + WS_MODS) + (size_t)L * 9 * NMODW)
    if (otid() < 4) ((volatile LAS unsigned*)(lds + LDS_CTL_OFF))[otid()] = 0u;
    __syncthreads();
    { KA(); (void)xcd_barrier_post((unsigned*)(ws + WS_BAR), (volatile LAS unsigned*)(lds + LDS_CTL_OFF)); }
    PH(0) for (int rep = 0; rep < REP_ADA; ++rep) { KA(); phase_ada_rope(a, ws, lds); __syncthreads(); }
#pragma unroll 1
    for (int L = 0; L < DEPTH; ++L) {
        __syncthreads();
        PH(1) for (int rep = 0; rep < REP_CONV; ++rep) { KA(); phase_conv_weights(a, ws, lds, L); __syncthreads(); }
        if (L == 0) GSYNC_CG();
#pragma unroll 1
        for (int s = 0; s < 2; ++s) {
            PH(2) for (int rep = 0; rep < REP_MN; ++rep) { KA(); phase_modnorm(a, ws, L, s ? 2 : 0, (L == 0) && (s == 0), (s == 0 && L > 0) ? 2 : 0); }
            GSYNC();
            PH(3) for (int rep = 0; rep < REP_W1; ++rep) {   KA();
                pg8::Gemm g{XNP, (const bfu*)(ws + (s ? WS_W1B : WS_W1A)), MR, 2 * FFD, DM, DM}; pg8::StaticOrder S; S.init(MR, 2 * FFD, ogrid(), obid());
                pg8::EpiSwiglu E{(bfu*)(ws + WS_BIG)};
                pg8::gemm_phase<pg8::EpiSwiglu, pg8::StaticOrder, true, true>(lds, g, S, E);
            }
            GSYNC();
            PH(4) for (int rep = 0; rep < REP_W2; ++rep) {   KA();
                {   pg8::Gemm g{(const bfu*)(ws + WS_BIG), (const bfu*)(ws + (s ? WS_W2B : WS_W2A)), MR, DM, FFD, FFD}; pg8::LatentOrder S; S.init(MR / 256, DM, ogrid(), obid());
                    pg8::EpiResid E{XP, MODSL + (s ? 8 : 2) * DM, 0.5f / REP_W2, 0};
                    pg8::gemm_phase<pg8::EpiResid, pg8::LatentOrder, true, true>(lds, g, S, E); }
                if (!(s && L == DEPTH - 1)) {
                    pg8::Gemm g{(const bfu*)(ws + WS_BIG), (const bfu*)(ws + (s ? WS_W2B : WS_W2A)), MR, DM, FFD, 256}; pg8::CtxSplitOrder S; S.init(MR / 256, DM, FFD, 256, ogrid(), obid());
                    pg8::EpiPartial E{(float*)(ws + WS_BIG + BIG_PART), 512, NBATCH * CTXL};
                    pg8::gemm_phase<pg8::EpiPartial, pg8::CtxSplitOrder, true, true>(lds, g, S, E); }
            }
            GSYNC();
            if (s == 0) {
                PH(2) for (int rep = 0; rep < REP_MN; ++rep) { KA(); phase_modnorm(a, ws, L, 1, false, 1); }
                GSYNC();
                if ((L & 1) == 0) {
#pragma unroll 1
                    for (int hf = 0; hf < 2; ++hf) {
                        PH(5) for (int rep = 0; rep < REP_INP; ++rep) {   KA(); pg8::Gemm g{XNP + (size_t)hf * MH * DM, (const bfu*)(ws + WS_WMIX + WMIX_QKG), MH, 4096, DM, DM}; pg8::StaticOrder S; S.init(MH, 4096, ogrid(), obid());
                            pg8::EpiRetQKG E{(bfu*)(ws + WS_BIG + BIG_QKG), (const float*)(ws + WS_COSR), (const float*)(ws + WS_SINR), hf * HTILES};
                            pg8::gemm_phase<pg8::EpiRetQKG, pg8::StaticOrder, true, true>(lds, g, S, E); }
                        PH(6) for (int rep = 0; rep < REP_INP; ++rep) {   KA(); pg8::Gemm g{(const bfu*)(ws + WS_WMIX + WMIX_KV), XNP + (size_t)hf * MH * DM, 3072, MH, DM, DM}; pg8::StaticOrder S; S.init(3072, MH, ogrid(), obid());
                            pg8::EpiRetKVT E{(bfu*)(ws + WS_BIG + BIG_KVT), (const float*)(ws + WS_COSRT), (const float*)(ws + WS_SINRT), hf * HTILES};
                            pg8::gemm_phase<pg8::EpiRetKVT, pg8::StaticOrder, true, true>(lds, g, S, E); }
                        GSYNC();
                        PH(8) for (int rep = 0; rep < REP_SCAN; ++rep) { KA(); phase_ret_scan(a, ws, lds, L >> 1); }
                        GSYNC();
                        PH(9) { KA(); phase_ret_merge(ws); }
                        GSYNC();
                        PH(10) {   KA(); pg8::Gemm g{(const bfu*)(ws + WS_BIG + BIG_OF), (const bfu*)(ws + WS_WMIX + WMIX_OUT), MH, DM, 2048, 2048}; pg8::StaticOrder S; S.init(MH, DM, ogrid(), obid());
                            pg8::EpiResid E{XP, MODSL + 5 * DM, 1.0f, hf * HTILES};
                            pg8::gemm_phase<pg8::EpiResid, pg8::StaticOrder, true, true>(lds, g, S, E); }
                        GSYNC();
                    }
                } else {
                    PH(11) {   KA(); pg8::Gemm g{XNP, (const bfu*)(ws + WS_WMIX + WMIX_AQKV), MR, 1536, DM, DM}; pg8::StaticOrder S; S.init(MR, 1536, ogrid(), obid());
                        pg8::EpiPlain E{(bfu*)(ws + WS_BIG + BIG_AQKV), 1536};
                        pg8::gemm_phase<pg8::EpiPlain, pg8::StaticOrder, true, true>(lds, g, S, E); }
                    GSYNC();
                    PH(12) { KA(); phase_qknorm(a, ws, L >> 1); }
                    GSYNC();
                    PH(13) for (int rep = 0; rep < REP_ATT; ++rep) { KA(); phase_attention(ws, (char*)lds_raw); }
                    GSYNC();
                    PH(14) {   KA(); pg8::Gemm g{(const bfu*)(ws + WS_BIG + BIG_AO), (const bfu*)(ws + WS_WMIX + WMIX_AO), MR, DM, DM, DM}; pg8::StaticOrder S; S.init(MR, DM, ogrid(), obid());
                        pg8::EpiResid E{XP, MODSL + 5 * DM, 1.0f, 0};
                        pg8::gemm_phase<pg8::EpiResid, pg8::StaticOrder, true, true>(lds, g, S, E); }
                    GSYNC();
                }
            }
        }
    }
    PH(15) { KA(); phase_final(a, ws); }
}

extern "C" void kernel_launch(void* const* d_in, const int* in_sizes, int n_in, void* d_out, int out_size, void* d_ws, size_t ws_size, hipStream_t stream) {
    static int grid = 0;
    if (grid == 0) {
        if (n_in != 18 || out_size != NBATCH * SEQ * DM || ws_size < WS_END) { fprintf(stderr, "kernel_launch: unexpected shapes: n_in %d out %d ws %zu (need %zu)\n", n_in, out_size, ws_size, (size_t)WS_END); grid = -1; return; }
        int dev = 0, cus = 0;
        if (hipGetDevice(&dev) != hipSuccess || hipDeviceGetAttribute(&cus, hipDeviceAttributeMultiprocessorCount, dev) != hipSuccess) { grid = -1; return; }
        if (hipFuncSetAttribute((const void*)fwd_kernel, hipFuncAttributeMaxDynamicSharedMemorySize, LDS_BYTES) != hipSuccess) { fprintf(stderr, "kernel_launch: hipFuncSetAttribute failed\n"); grid = -1; return; }
        int per = 0;
        if (hipOccupancyMaxActiveBlocksPerMultiprocessor(&per, (const void*)fwd_kernel, NTHR, LDS_BYTES) != hipSuccess || per < 1) fprintf(stderr, "kernel_launch: occupancy query says %d\n", per);
        (void)hipGetLastError();
        grid = cus;
    }
    if (grid < 0) return;
    if (hipMemsetAsync((char*)d_ws + WS_BAR, 0, WS_BAR_BYTES, stream) != hipSuccess) { fprintf(stderr, "kernel_launch: memset of the barrier words failed\n"); return; }
    Args a{};
    const float** ap = (const float**)&a;
    for (int i = 0; i < 18; ++i) ap[i] = (const float*)d_in[i];
    a.out = (float*)d_out; a.ws = (unsigned char*)d_ws;
    void* args[] = {&a};
    hipError_t e = hipLaunchCooperativeKernel((const void*)fwd_kernel, dim3(grid), dim3(NTHR), args, LDS_BYTES, stream);
    if (e != hipSuccess) fprintf(stderr, "kernel_launch: cooperative launch failed: %s (grid %d)\n", hipGetErrorString(e), grid);
}
```

```cpp
#include <hip/hip_runtime.h>
#include <hip/hip_cooperative_groups.h>
#include <hip/hip_bf16.h>
#include <cstdio>
#include <cstdint>
namespace cg = cooperative_groups;
__device__ __forceinline__ int otid() { int t = threadIdx.x; asm volatile("" : "+v"(t)); return t; }
__device__ __forceinline__ int obid() { int t = blockIdx.x; asm volatile("" : "+s"(t)); return t; }
__device__ __forceinline__ int ogrid() { int t = gridDim.x; asm volatile("" : "+s"(t)); return t; }
namespace pg8 {
#define PG8_LAS __attribute__((address_space(3)))
typedef unsigned short bf16_t;
typedef short bf16x8 __attribute__((ext_vector_type(8)));
typedef float f32x4 __attribute__((ext_vector_type(4)));
typedef unsigned u32x4 __attribute__((ext_vector_type(4)));
constexpr int BM = 256, BK = 64, HALF = 128, HTB = HALF * BK * 2  , STAGE_BYTES = 8 * HTB, NXCD = 8, WGM = 8;

__host__ __device__ __forceinline__ int lds_byte(int r, int c) { const int st = (r >> 4) * 2 + (c >> 5), rr = r & 15, cc = c & 31, ob = rr * 64 + cc * 2; return st * 1024 + (ob ^ (((ob >> 9) & 1) << 5)); }
__host__ __device__ __forceinline__ void stage_rc(int b, int& R, int& C) { const int st = b / 1024, sb = b % 1024, swz = sb ^ (((sb >> 9) & 1) << 5); R = (st >> 1) * 16 + swz / 64; C = (st & 1) * 32 + (swz % 64) / 2; }
__host__ __device__ __forceinline__ int perm32(int rho) { const int n = rho >> 4, i = rho & 15; return 8 * (i >> 2) + 4 * n + (i & 3); }

struct Unit { int pm, pn, kb; };
struct Gemm { const bf16_t* A; const bf16_t* Bt; int M, N, K, Kl; };

struct StaticOrder {
    int nM, nN, nwg, G, c;
    __host__ __device__ void init(int M, int N, int G_, int c_) { nM = M / BM; nN = N / BM; nwg = nM * nN; G = G_; c = c_; }
    __host__ __device__ bool next(int i, Unit& u) const {
        const long L = (long)i * G + c; if (L >= nwg) return false;
        int wgid = (int)L; { const int q = nwg / NXCD, r = nwg % NXCD, xcd = wgid % NXCD, off = wgid / NXCD; wgid = (xcd < r ? xcd * (q + 1) : r * (q + 1) + (xcd - r) * q) + off; }
        const int nig = WGM * nN, gid = wgid / nig, fm = gid * WGM, gsz = (nM - fm) < WGM ? (nM - fm) : WGM;
        u.pm = fm + ((wgid % nig) % gsz); u.pn = (wgid % nig) / gsz; u.kb = 0; return true;
    }
    __device__ __forceinline__ void a_ready(const Unit&) const {}
    __device__ __forceinline__ void done(const Unit&) const {}
};

struct LatentOrder {
    StaticOrder so;
    __host__ __device__ void init(int Mtiles_all, int N, int G_, int c_) { so.init((Mtiles_all / 17) * 16 * BM, N, G_, c_); }
    __host__ __device__ bool next(int i, Unit& u) const { if (!so.next(i, u)) return false; u.pm = u.pm + (u.pm >> 4); return true; }
    __device__ __forceinline__ void a_ready(const Unit&) const {}
    __device__ __forceinline__ void done(const Unit&) const {}
};
struct CtxSplitOrder {
    int nctx, nN, nks, klb, G, c;
    __host__ __device__ void init(int Mtiles_all, int N, int K, int kl, int G_, int c_) { nctx = Mtiles_all / 17; nN = N / BM; nks = K / kl; klb = kl * 2; G = G_; c = c_; }
    __host__ __device__ bool next(int i, Unit& u) const {
        const int L = i * G + c; const int per = nctx * nN; if (L >= per * nks) return false;
        const int ks = L / per, t = L - ks * per; u.pn = t % nN; u.pm = 17 * (t / nN) + 16; u.kb = ks * klb; return true;
    }
    __device__ __forceinline__ void a_ready(const Unit&) const {}
    __device__ __forceinline__ void done(const Unit&) const {}
};
__device__ __forceinline__ unsigned cvt_pk_bf16(float lo, float hi) { unsigned r; asm volatile("v_cvt_pk_bf16_f32 %0, %1, %2" : "=v"(r) : "v"(lo), "v"(hi)); return r; }
typedef float f32x2 __attribute__((ext_vector_type(2)));
constexpr int DM = 1024, NBATCH = 8, SEQ = 4096, CTXL = 256, RPB = SEQ + CTXL, MR = NBATCH * RPB, MH = MR / 2, TPB = RPB / 256, HTILES = MH / 256;
constexpr int FFD = 2816, NMODW = 9 * DM;
__device__ __forceinline__ float bf2f(unsigned short s) { return __uint_as_float(((unsigned)s) << 16); }
__device__ __forceinline__ float fast_silu(float x) { return x * __builtin_amdgcn_rcpf(1.0f + __builtin_amdgcn_exp2f(-1.4426950408889634f * x)); }

struct EpiSwiglu {
    static constexpr bool PERM = true, AFTER_DRAIN = false;
    bf16_t* H;
    __device__ __forceinline__ void operator()(const f32x4 (&acc)[2][2][4][2], const Unit& u, int wr, int wc, int fr, int fq) const {
        const int row0 = u.pm * BM + wr * 64 + fr; const int col0 = u.pn * HALF + wc * 32 + 8 * fq;
#pragma unroll
        for (int ai = 0; ai < 2; ++ai)
#pragma unroll
            for (int m = 0; m < 4; ++m) {
                bf16_t* rowp = H + (size_t)(row0 + ai * HALF + m * 16) * FFD + col0;
                const f32x4 g0 = acc[ai][0][m][0], g1 = acc[ai][0][m][1], u0 = acc[ai][1][m][0], u1 = acc[ai][1][m][1];
                u32x4 w;
                w.x = cvt_pk_bf16(fast_silu(g0[0]) * u0[0], fast_silu(g0[1]) * u0[1]); w.y = cvt_pk_bf16(fast_silu(g0[2]) * u0[2], fast_silu(g0[3]) * u0[3]);
                w.z = cvt_pk_bf16(fast_silu(g1[0]) * u1[0], fast_silu(g1[1]) * u1[1]); w.w = cvt_pk_bf16(fast_silu(g1[2]) * u1[2], fast_silu(g1[3]) * u1[3]);
                *(u32x4*)rowp = w;
            }
    }
};
struct EpiResid {
    static constexpr bool PERM = true, AFTER_DRAIN = false;
    float* X; const float* gate  ; float gs; int pm_off;
    __device__ __forceinline__ void operator()(const f32x4 (&acc)[2][2][4][2], const Unit& u, int wr, int wc, int fr, int fq) const {
        const int pmg = u.pm + pm_off; const int bb = pmg / TPB, within = pmg - bb * TPB; const int mrow = (within == TPB - 1) ? 8 : bb;
        const int col0 = u.pn * BM + wc * 32 + 8 * fq; const float* gp = gate + (size_t)mrow * NMODW + col0;
        f32x4 gv[2][2];
#pragma unroll
        for (int bj = 0; bj < 2; ++bj)
#pragma unroll
            for (int n = 0; n < 2; ++n) gv[bj][n] = *(const f32x4*)(gp + bj * HALF + n * 4) * gs;
        const int row0 = pmg * BM + wr * 64 + fr;
#pragma unroll
        for (int ai = 0; ai < 2; ++ai)
#pragma unroll
            for (int m = 0; m < 4; ++m) {
                float* rowp = X + (size_t)(row0 + ai * HALF + m * 16) * DM + col0;
#pragma unroll
                for (int bj = 0; bj < 2; ++bj)
#pragma unroll
                    for (int n = 0; n < 2; ++n) { f32x4* p = (f32x4*)(rowp + bj * HALF + n * 4); *p = *p + gv[bj][n] * acc[ai][bj][m][n]; }
            }
    }
};
struct EpiPartial {
    static constexpr bool PERM = true, AFTER_DRAIN = false;
    float* P; int klb, nrows;
    __device__ __forceinline__ void operator()(const f32x4 (&acc)[2][2][4][2], const Unit& u, int wr, int wc, int fr, int fq) const {
        const int ks = u.kb / klb, ci = u.pm / TPB; const int col0 = u.pn * BM + wc * 32 + 8 * fq;
        float* base = P + ((size_t)ks * nrows + ci * BM + wr * 64 + fr) * DM + col0;
#pragma unroll
        for (int ai = 0; ai < 2; ++ai)
#pragma unroll
            for (int m = 0; m < 4; ++m) { float* rowp = base + (size_t)(ai * HALF + m * 16) * DM;
#pragma unroll
                for (int bj = 0; bj < 2; ++bj) { *(f32x4*)(rowp + bj * HALF) = acc[ai][bj][m][0]; *(f32x4*)(rowp + bj * HALF + 4) = acc[ai][bj][m][1]; } }
    }
};
struct EpiPlain {
    static constexpr bool PERM = true, AFTER_DRAIN = false;
    bf16_t* O; int ldc;
    __device__ __forceinline__ void operator()(const f32x4 (&acc)[2][2][4][2], const Unit& u, int wr, int wc, int fr, int fq) const {
        const int row0 = u.pm * BM + wr * 64 + fr; const int col0 = u.pn * BM + wc * 32 + 8 * fq;
#pragma unroll
        for (int ai = 0; ai < 2; ++ai)
#pragma unroll
            for (int m = 0; m < 4; ++m) { bf16_t* rowp = O + (size_t)(row0 + ai * HALF + m * 16) * ldc + col0;
#pragma unroll
                for (int bj = 0; bj < 2; ++bj) { const f32x4 v0 = acc[ai][bj][m][0], v1 = acc[ai][bj][m][1]; u32x4 w;
                    w.x = cvt_pk_bf16(v0[0], v0[1]); w.y = cvt_pk_bf16(v0[2], v0[3]); w.z = cvt_pk_bf16(v1[0], v1[1]); w.w = cvt_pk_bf16(v1[2], v1[3]);
                    *(u32x4*)(rowp + bj * HALF) = w; } }
    }
};
struct EpiRetQKG {
    static constexpr bool PERM = true, AFTER_DRAIN = false;
    bf16_t* O; const float* cosR; const float* sinR;   int pm_off;
    __device__ __forceinline__ void operator()(const f32x4 (&acc)[2][2][4][2], const Unit& u, int wr, int wc, int fr, int fq) const {
        const int pmg = u.pm + pm_off; const int bb = pmg / TPB, within = pmg - bb * TPB; const bool latent = within < TPB - 1;
        const int row0 = u.pm * BM + wr * 64 + fr; const int jc = wc * 32 + 8 * fq; const int col0 = u.pn * BM + jc;
        const bool isg = u.pn >= 8;
#pragma unroll
        for (int ai = 0; ai < 2; ++ai)
#pragma unroll
            for (int m = 0; m < 4; ++m) {
                const int rl = ai * HALF + wr * 64 + m * 16 + fr;
                bf16_t* rowp = O + (size_t)(u.pm * BM + rl) * 4096 + col0;
                f32x4 a0 = acc[ai][0][m][0], a1 = acc[ai][0][m][1], b0 = acc[ai][1][m][0], b1 = acc[ai][1][m][1];
                if (isg) {
#pragma unroll
                    for (int i = 0; i < 4; ++i) { a0[i] = fast_silu(a0[i]); a1[i] = fast_silu(a1[i]); b0[i] = fast_silu(b0[i]); b1[i] = fast_silu(b1[i]); }
                } else if (latent) {
                    const int pos = within * BM + rl;
                    const f32x4 c0 = *(const f32x4*)(cosR + (size_t)pos * 128 + jc), c1 = *(const f32x4*)(cosR + (size_t)pos * 128 + jc + 4);
                    const f32x4 s0 = *(const f32x4*)(sinR + (size_t)pos * 128 + jc), s1 = *(const f32x4*)(sinR + (size_t)pos * 128 + jc + 4);
                    const f32x4 x0 = a0 * c0 - b0 * s0, y0 = b0 * c0 + a0 * s0, x1 = a1 * c1 - b1 * s1, y1 = b1 * c1 + a1 * s1;
                    a0 = x0; b0 = y0; a1 = x1; b1 = y1;
                }
                u32x4 w; w.x = cvt_pk_bf16(a0[0], a0[1]); w.y = cvt_pk_bf16(a0[2], a0[3]); w.z = cvt_pk_bf16(a1[0], a1[1]); w.w = cvt_pk_bf16(a1[2], a1[3]);
                *(u32x4*)rowp = w;
                w.x = cvt_pk_bf16(b0[0], b0[1]); w.y = cvt_pk_bf16(b0[2], b0[3]); w.z = cvt_pk_bf16(b1[0], b1[1]); w.w = cvt_pk_bf16(b1[2], b1[3]);
                *(u32x4*)(rowp + HALF) = w;
            }
        (void)row0;
    }
};
struct EpiRetKVT {
    static constexpr bool PERM = true, AFTER_DRAIN = false;
    bf16_t* O; const float* cosT; const float* sinT;   int pn_off;
    __device__ __forceinline__ void operator()(const f32x4 (&acc)[2][2][4][2], const Unit& u, int wr, int wc, int fr, int fq) const {
        const int png = u.pn + pn_off; const int bb = png / TPB, within = png - bb * TPB; const bool rot = (within < TPB - 1) && (u.pm < 4);
        const int tc = wc * 32 + 8 * fq;
#pragma unroll
        for (int m = 0; m < 4; ++m) {
            const int j = wr * 64 + m * 16 + fr;
#pragma unroll
            for (int bj = 0; bj < 2; ++bj) {
                f32x4 a0 = acc[0][bj][m][0], a1 = acc[0][bj][m][1], b0 = acc[1][bj][m][0], b1 = acc[1][bj][m][1];
                if (rot) {
                    const int pos = within * BM + bj * HALF + tc;
                    const f32x4 c0 = *(const f32x4*)(cosT + (size_t)j * SEQ + pos), c1 = *(const f32x4*)(cosT + (size_t)j * SEQ + pos + 4);
                    const f32x4 s0 = *(const f32x4*)(sinT + (size_t)j * SEQ + pos), s1 = *(const f32x4*)(sinT + (size_t)j * SEQ + pos + 4);
                    const f32x4 x0 = a0 * c0 - b0 * s0, y0 = b0 * c0 + a0 * s0, x1 = a1 * c1 - b1 * s1, y1 = b1 * c1 + a1 * s1;
                    a0 = x0; b0 = y0; a1 = x1; b1 = y1;
                }
                bf16_t* p0 = O + (size_t)(u.pm * BM + j) * MH + u.pn * BM + bj * HALF + tc;
                u32x4 w; w.x = cvt_pk_bf16(a0[0], a0[1]); w.y = cvt_pk_bf16(a0[2], a0[3]); w.z = cvt_pk_bf16(a1[0], a1[1]); w.w = cvt_pk_bf16(a1[2], a1[3]);
                *(u32x4*)p0 = w;
                w.x = cvt_pk_bf16(b0[0], b0[1]); w.y = cvt_pk_bf16(b0[2], b0[3]); w.z = cvt_pk_bf16(b1[0], b1[1]); w.w = cvt_pk_bf16(b1[2], b1[3]);
                *(u32x4*)(p0 + (size_t)HALF * MH) = w;
            }
        }
    }
};
template <class Epi, class Sched, bool ALIGN_EPI = false, bool SP2 = false>
__device__ __forceinline__ void gemm_phase(PG8_LAS unsigned char* lds, const Gemm g, const Sched& S, const Epi& E) {
    const int tid = otid(), wid = __builtin_amdgcn_readfirstlane(tid >> 6), lane = tid & 63, wr = wid >> 2, wc = wid & 3, fr = lane & 15, fq = lane >> 4;
    const int K = g.K, nt = g.Kl / BK;
    unsigned voffA[2], voffB[2];
#pragma unroll
    for (int i = 0; i < 2; ++i) { int R, C; stage_rc(tid * 16 + i * 8192, R, C); const int Rb = Epi::PERM ? ((R & ~31) + perm32(R & 31)) : R;
        voffA[i] = (unsigned)(R * K + C) * 2u; voffB[i] = (unsigned)(Rb * K + C) * 2u; }
    const size_t kstep = (size_t)(BK * 2);
    const size_t hstep = (size_t)HALF * K * 2;
    const size_t tstep = 2 * hstep;
    const unsigned ldsw = (unsigned)wid * 1024u;
    const int aoff = lds_byte(wr * 64 + fr, fq * 8), boff = lds_byte(wc * 32 + fr, fq * 8);
#define PG8_SA(b, h) (((b) * 2 + (h)) * HTB)
#define PG8_SB(b, h) ((4 + (b) * 2 + (h)) * HTB)
#define PG8_STAGE(bufoff, gbase, voff) do { _Pragma("unroll") for (int _i = 0; _i < 2; ++_i) \
        __builtin_amdgcn_global_load_lds((const unsigned*)((const char*)(gbase) + (voff)[_i]), (PG8_LAS unsigned*)(lds + (bufoff) + ldsw + _i * 8192), 16, 0, 0); } while (0)
#define PG8_LDA(dst, b, h) do { _Pragma("unroll") for (int m = 0; m < 4; ++m) _Pragma("unroll") for (int k = 0; k < 2; ++k) dst[m][k] = *(const PG8_LAS bf16x8*)(lds + PG8_SA(b, h) + aoff + m * 2048 + k * 1024); } while (0)
#define PG8_LDB(dst, b, h) do { _Pragma("unroll") for (int n = 0; n < 2; ++n) _Pragma("unroll") for (int k = 0; k < 2; ++k) dst[n][k] = *(const PG8_LAS bf16x8*)(lds + PG8_SB(b, h) + boff + n * 2048 + k * 1024); } while (0)
#define PG8_MMA(ai, bj, At, Bt) do { __builtin_amdgcn_s_setprio(1); _Pragma("unroll") for (int m = 0; m < 4; ++m) _Pragma("unroll") for (int n = 0; n < 2; ++n) _Pragma("unroll") for (int k = 0; k < 2; ++k) \
        acc[ai][bj][m][n] = __builtin_amdgcn_mfma_f32_16x16x32_bf16(Bt[n][k], At[m][k], acc[ai][bj][m][n], 0, 0, 0); __builtin_amdgcn_s_setprio(0); } while (0)
#define PG8_WAIT_V(n) asm volatile("s_waitcnt vmcnt(" #n ")" ::: "memory")
#define PG8_WAIT_L(n) asm volatile("s_waitcnt lgkmcnt(" #n ")" ::: "memory")
#define PG8_BAR __builtin_amdgcn_s_barrier()
#define PG8_SCHED __builtin_amdgcn_sched_barrier(0)
    Unit cur, nxt; int ui = 0;
    if (!S.next(0, cur)) return;
    f32x4 acc[2][2][4][2];
#pragma unroll
    for (int a = 0; a < 2; ++a)
#pragma unroll
        for (int b = 0; b < 2; ++b)
#pragma unroll
            for (int m = 0; m < 4; ++m)
#pragma unroll
                for (int n = 0; n < 2; ++n) acc[a][b][m][n] = (f32x4){0.f, 0.f, 0.f, 0.f};
    bf16x8 At[4][2], B0[2][2], B1[2][2];
    const char* cA = (const char*)g.A + (size_t)cur.pm * tstep + cur.kb; const char* cB = (const char*)g.Bt + (size_t)cur.pn * tstep + cur.kb;
    S.a_ready(cur);
    if constexpr (SP2) {
        PG8_STAGE(PG8_SB(0, 0), cB, voffB); PG8_STAGE(PG8_SB(0, 1), cB + hstep, voffB); PG8_STAGE(PG8_SA(0, 0), cA, voffA); PG8_STAGE(PG8_SA(0, 1), cA + hstep, voffA);
        if (wr == 1) PG8_BAR;
        PG8_WAIT_V(2); PG8_BAR;
        PG8_STAGE(PG8_SB(1, 0), cB + kstep, voffB); PG8_STAGE(PG8_SA(1, 0), cA + kstep, voffA); PG8_STAGE(PG8_SB(1, 1), cB + hstep + kstep, voffB);
        PG8_WAIT_V(6); PG8_BAR;
    } else {
        PG8_STAGE(PG8_SB(0, 0), cB, voffB); PG8_STAGE(PG8_SA(0, 0), cA, voffA); PG8_STAGE(PG8_SB(0, 1), cB + hstep, voffB); PG8_STAGE(PG8_SA(0, 1), cA + hstep, voffA);
        if (wr == 1) PG8_BAR;
        PG8_WAIT_V(4); PG8_BAR;
        PG8_STAGE(PG8_SB(1, 0), cB + kstep, voffB); PG8_STAGE(PG8_SA(1, 0), cA + kstep, voffA); PG8_STAGE(PG8_SB(1, 1), cB + hstep + kstep, voffB);
        PG8_WAIT_V(6); PG8_BAR;
    }
    for (;;) {
        const bool has_next = S.next(ui + 1, nxt);
        const char* nA = has_next ? (const char*)g.A + (size_t)nxt.pm * tstep + nxt.kb : cA; const char* nB = has_next ? (const char*)g.Bt + (size_t)nxt.pn * tstep + nxt.kb : cB;
        for (int t = 0; t < nt; t += 2) {
            const bool last = (t == nt - 2);
            const char* a1 = cA + (size_t)(t + 1) * kstep;
            const char* a2 = last ? nA : cA + (size_t)(t + 2) * kstep; const char* b2 = last ? nB : cB + (size_t)(t + 2) * kstep;
            const char* a3 = a2 + kstep; const char* b3 = b2 + kstep;
            if (last && has_next) S.a_ready(nxt);
            if constexpr (SP2) {
            PG8_LDB(B0, 0, 0); PG8_LDB(B1, 0, 1); PG8_SCHED; PG8_LDA(At, 0, 0); PG8_STAGE(PG8_SA(1, 1), a1 + hstep, voffA);
            PG8_WAIT_V(8); PG8_WAIT_L(0); PG8_BAR; PG8_MMA(0, 0, At, B0); PG8_MMA(0, 1, At, B1); PG8_BAR; PG8_SCHED;
            PG8_LDA(At, 0, 1); PG8_STAGE(PG8_SB(0, 0), b2, voffB); PG8_STAGE(PG8_SB(0, 1), b2 + hstep, voffB); PG8_STAGE(PG8_SA(0, 0), a2, voffA);
            PG8_WAIT_V(8); PG8_WAIT_L(0); PG8_BAR; PG8_MMA(1, 0, At, B0); PG8_MMA(1, 1, At, B1); PG8_BAR; PG8_SCHED;
            PG8_LDB(B0, 1, 0); PG8_LDB(B1, 1, 1); PG8_SCHED; PG8_LDA(At, 1, 0); PG8_STAGE(PG8_SA(0, 1), a2 + hstep, voffA);
            PG8_WAIT_V(8); PG8_WAIT_L(0); PG8_BAR; PG8_MMA(0, 0, At, B0); PG8_MMA(0, 1, At, B1); PG8_BAR; PG8_SCHED;
            PG8_LDA(At, 1, 1); PG8_STAGE(PG8_SB(1, 0), b3, voffB); PG8_STAGE(PG8_SB(1, 1), b3 + hstep, voffB); PG8_STAGE(PG8_SA(1, 0), a3, voffA);
            PG8_WAIT_V(8); PG8_WAIT_L(0); PG8_BAR; PG8_MMA(1, 0, At, B0); PG8_MMA(1, 1, At, B1); PG8_BAR; PG8_SCHED;
            } else {
            PG8_LDB(B0, 0, 0); PG8_SCHED; PG8_LDA(At, 0, 0); PG8_STAGE(PG8_SA(1, 1), a1 + hstep, voffA);
            PG8_WAIT_L(8); PG8_BAR; PG8_WAIT_L(0); PG8_MMA(0, 0, At, B0); PG8_BAR; PG8_SCHED;
            PG8_LDB(B1, 0, 1); PG8_STAGE(PG8_SB(0, 0), b2, voffB);
            PG8_BAR; PG8_WAIT_L(0); PG8_MMA(0, 1, At, B1); PG8_BAR;
            PG8_LDA(At, 0, 1); PG8_STAGE(PG8_SA(0, 0), a2, voffA);
            PG8_BAR; PG8_WAIT_L(0); PG8_MMA(1, 0, At, B0); PG8_BAR; PG8_SCHED;
            PG8_STAGE(PG8_SB(0, 1), b2 + hstep, voffB);
            PG8_WAIT_V(6); PG8_BAR; PG8_MMA(1, 1, At, B1); PG8_BAR;
            PG8_LDB(B0, 1, 0); PG8_SCHED; PG8_LDA(At, 1, 0); PG8_STAGE(PG8_SA(0, 1), a2 + hstep, voffA);
            PG8_WAIT_L(8); PG8_BAR; PG8_WAIT_L(0); PG8_MMA(0, 0, At, B0); PG8_BAR; PG8_SCHED;
            PG8_LDB(B1, 1, 1); PG8_STAGE(PG8_SB(1, 0), b3, voffB);
            PG8_BAR; PG8_WAIT_L(0); PG8_MMA(0, 1, At, B1); PG8_BAR;
            PG8_LDA(At, 1, 1); PG8_STAGE(PG8_SA(1, 0), a3, voffA);
            PG8_BAR; PG8_WAIT_L(0); PG8_MMA(1, 0, At, B0); PG8_BAR; PG8_SCHED;
            PG8_STAGE(PG8_SB(1, 1), b3 + hstep, voffB);
            PG8_WAIT_V(6); PG8_BAR; PG8_MMA(1, 1, At, B1); PG8_BAR;
            }
        }
        if constexpr (ALIGN_EPI) { if (wr == 0) PG8_BAR; }
        if constexpr (!Epi::AFTER_DRAIN) { asm volatile("s_nop 15\n\ts_nop 7" ::: "memory");
            E(acc, cur, wr, wc, fr, fq); S.done(cur); }
        if (!has_next) break;
#pragma unroll
        for (int a = 0; a < 2; ++a)
#pragma unroll
            for (int b = 0; b < 2; ++b)
#pragma unroll
                for (int m = 0; m < 4; ++m)
#pragma unroll
                    for (int n = 0; n < 2; ++n) acc[a][b][m][n] = (f32x4){0.f, 0.f, 0.f, 0.f};
        cur = nxt; cA = nA; cB = nB; ++ui;
        if constexpr (ALIGN_EPI) { if (wr == 1) PG8_BAR; }
    }
    PG8_WAIT_V(0);
    if constexpr (!ALIGN_EPI) { if (wr == 0) PG8_BAR; }
    PG8_BAR;
    if constexpr (Epi::AFTER_DRAIN) { E.fused(acc, cur, wr, wc, fr, fq, lds, wid, lane); S.done(cur); }
#undef PG8_SA
#undef PG8_SB
#undef PG8_STAGE
#undef PG8_LDA
#undef PG8_LDB
#undef PG8_MMA
#undef PG8_WAIT_V
#undef PG8_WAIT_L
#undef PG8_BAR
#undef PG8_SCHED
}
}

namespace attn {
using bf16 = __hip_bfloat16;
constexpr int D = 128, NW = 8, QBLK = 32, KVBLK = 64;
constexpr float SCALE = 0.088388347648318440f;
constexpr float THR = 8.f;
constexpr int LDQ = 1536, LDK = 1536, LDO = 1024;
constexpr size_t SHM_V = KVBLK * D * 2, SHM_K = KVBLK * D * 2, SHM_ATTN = 2 * SHM_V + 2 * SHM_K + NW * 64 * 4;
using bf16x8 = __attribute__((ext_vector_type(8))) short;
using s16x4  = __attribute__((ext_vector_type(4))) short;
using f32x16 = __attribute__((ext_vector_type(16))) float;
using u32x4  = __attribute__((ext_vector_type(4))) unsigned;
#define KSWZ(row, colB) ((row) * 256 + ((colB) ^ (((row) & 7) << 4)))
#define SBAR() __builtin_amdgcn_sched_barrier(0)
__device__ __forceinline__ int crow(int r, int hi) { return (r & 3) + 8 * (r >> 2) + 4 * hi; }
__device__ __forceinline__ unsigned cvtpk(float lo, float hi) { unsigned r; asm volatile("v_cvt_pk_bf16_f32 %0, %1, %2" : "=v"(r) : "v"(lo), "v"(hi)); return r; }
__device__ __forceinline__ void partialSM(f32x16& p0, f32x16& p1, float& m_reg, float& mn, float& alpha) {
  constexpr float C = SCALE * 1.4426950408889634f;
  float pmax = p0[0]; for (int r = 1; r < 16; ++r) pmax = fmaxf(pmax, p0[r]); for (int r = 0; r < 16; ++r) pmax = fmaxf(pmax, p1[r]);
  { auto rr = __builtin_amdgcn_permlane32_swap(__float_as_uint(pmax), __float_as_uint(pmax), false, false);
    pmax = fmaxf(__uint_as_float(rr[0]), __uint_as_float(rr[1])); }
  if (__builtin_expect(__all(pmax - m_reg <= THR / SCALE), 1)) { mn = m_reg; alpha = 1.f; }
  else { mn = fmaxf(m_reg, pmax); alpha = __builtin_amdgcn_exp2f((m_reg - mn) * C); m_reg = mn; }
  float mnC = -mn * C;
  for (int r = 0; r < 16; ++r) p0[r] = fmaf(p0[r], C, mnC); for (int r = 0; r < 16; ++r) p1[r] = fmaf(p1[r], C, mnC);
  for (int r = 0; r < 16; ++r) p0[r] = __builtin_amdgcn_exp2f(p0[r]);
}
__device__ __forceinline__ void finishSM(f32x16& p0, f32x16& p1, float alpha, float& l_reg, bf16x8& pa0, bf16x8& pa1, bf16x8& pa2, bf16x8& pa3) {
  for (int r = 0; r < 16; ++r) p1[r] = __builtin_amdgcn_exp2f(p1[r]);
  float ps = 0; for (int r = 0; r < 16; ++r) ps += p0[r]; for (int r = 0; r < 16; ++r) ps += p1[r];
  { auto rr = __builtin_amdgcn_permlane32_swap(__float_as_uint(ps), __float_as_uint(ps), false, false);
    ps = __uint_as_float(rr[0]) + __uint_as_float(rr[1]); }
  l_reg = l_reg * alpha + ps;
#define PK4(P, BASE, OUT) do { unsigned a0 = cvtpk(P[BASE + 0], P[BASE + 1]), a1 = cvtpk(P[BASE + 2], P[BASE + 3]);   \
    unsigned b0 = cvtpk(P[BASE + 4], P[BASE + 5]), b1 = cvtpk(P[BASE + 6], P[BASE + 7]);                              \
    auto r0 = __builtin_amdgcn_permlane32_swap(a0, b0, false, false); auto r1 = __builtin_amdgcn_permlane32_swap(a1, b1, false, false); \
    u32x4 w = {r0[0], r1[0], r0[1], r1[1]}; OUT = *reinterpret_cast<bf16x8*>(&w); } while (0)
  PK4(p0, 0, pa0); PK4(p0, 8, pa1); PK4(p1, 0, pa2); PK4(p1, 8, pa3);
#undef PK4
}
__device__ __forceinline__ void qkt(f32x16& p0, f32x16& p1, const bf16* Ks, const bf16x8* qr, int r32, int hi) {
  p0 = f32x16{}; p1 = f32x16{};
  for (int d0 = 0; d0 < 8; ++d0) { int cb = (d0 * 16 + hi * 8) * 2;
    bf16x8 b0 = *reinterpret_cast<const bf16x8*>((const char*)Ks + KSWZ(r32, cb));
    bf16x8 b1 = *reinterpret_cast<const bf16x8*>((const char*)Ks + KSWZ(32 + r32, cb));
    p0 = __builtin_amdgcn_mfma_f32_32x32x16_bf16(b0, qr[d0], p0, 0, 0, 0);
    p1 = __builtin_amdgcn_mfma_f32_32x32x16_bf16(b1, qr[d0], p1, 0, 0, 0); }
}
__device__ __forceinline__ int v_st(int k, int c) { const int kk = (k & ~0xC) | ((k & 4) << 1) | ((k & 8) >> 1); return ((kk >> 3) * 4 + (c >> 5)) * 512 + ((kk & 7) * 32 + (c & 31)) * 2; }
__device__ __forceinline__ int v_rd_base(int lane) { return ((lane & 3) << 3) | (((lane >> 2) & 3) << 6) | (((lane >> 4) & 1) << 5) | (((lane >> 5) & 1) << 8); }
constexpr int v_rd_off(int d0, int ks, int half) { return d0 * 512 + ks * 4096 + half * 2048; }
template <int OFF> __device__ __forceinline__ s16x4 tr_read(int vb) {
  s16x4 r; asm volatile("ds_read_b64_tr_b16 %0, %1 offset:%2" : "=&v"(r) : "v"(vb), "i"(OFF) : "memory"); return r;
}
template <int D0> __device__ __forceinline__ void pv_one(f32x16& od, int vb, bf16x8 pa0, bf16x8 pa1, bf16x8 pa2, bf16x8 pa3) {
  const s16x4 l0 = tr_read<v_rd_off(D0, 0, 0)>(vb), h0 = tr_read<v_rd_off(D0, 0, 1)>(vb), l1 = tr_read<v_rd_off(D0, 1, 0)>(vb), h1 = tr_read<v_rd_off(D0, 1, 1)>(vb);
  const s16x4 l2 = tr_read<v_rd_off(D0, 2, 0)>(vb), h2 = tr_read<v_rd_off(D0, 2, 1)>(vb), l3 = tr_read<v_rd_off(D0, 3, 0)>(vb), h3 = tr_read<v_rd_off(D0, 3, 1)>(vb);
  asm volatile("s_waitcnt lgkmcnt(0)" ::: "memory"); SBAR();
#define PK(L, H) (bf16x8){L[0], L[1], L[2], L[3], H[0], H[1], H[2], H[3]}
  od = __builtin_amdgcn_mfma_f32_32x32x16_bf16(pa0, PK(l0, h0), od, 0, 0, 0);
  od = __builtin_amdgcn_mfma_f32_32x32x16_bf16(pa1, PK(l1, h1), od, 0, 0, 0);
  od = __builtin_amdgcn_mfma_f32_32x32x16_bf16(pa2, PK(l2, h2), od, 0, 0, 0);
  od = __builtin_amdgcn_mfma_f32_32x32x16_bf16(pa3, PK(l3, h3), od, 0, 0, 0);
#undef PK
}
__device__ __forceinline__ void pv_d0(f32x16* o, int vb, bf16x8 pa0, bf16x8 pa1, bf16x8 pa2, bf16x8 pa3) {
  pv_one<0>(o[0], vb, pa0, pa1, pa2, pa3); pv_one<1>(o[1], vb, pa0, pa1, pa2, pa3); pv_one<2>(o[2], vb, pa0, pa1, pa2, pa3); pv_one<3>(o[3], vb, pa0, pa1, pa2, pa3);
}
__device__ __forceinline__ void attn_dense_body(const bf16* __restrict__ Qb, const bf16* __restrict__ Kh, const bf16* __restrict__ Vh,
                                                bf16* __restrict__ Ob, int seq, char* lds) {
  constexpr int SDEPTH = 2;
  const int tid = otid(), wid = tid >> 6, lane = tid & 63, r32 = lane & 31, hi = lane >> 5;
  bf16* V_lds = (bf16*)lds; bf16* K_lds = (bf16*)(lds + 2 * SHM_V);
  float* ws = (float*)(lds + 2 * SHM_V + 2 * SHM_K) + wid * 64; float* li_l = ws; float* al_l = ws + 32;
  float m_reg = -1e30f, l_reg = 0; f32x16 o[4] = {}; bf16x8 qr[8];
  const bf16* Qw = Qb + (long)(wid * QBLK + r32) * LDQ + hi * 8;
#pragma unroll
  for (int d0 = 0; d0 < 8; ++d0) qr[d0] = *reinterpret_cast<const bf16x8*>(Qw + d0 * 16);
  const int sr = tid >> 4, sc = (tid & 15) * 8, vst0 = v_st(sr, sc), vst1 = v_st(32 + sr, sc);
  const int vb0 = (int)(uintptr_t)V_lds + v_rd_base(lane);
  struct { bf16x8 vs0, vs1, ks0, ks1; } sr_[SDEPTH];
#define SLOAD(i, k0) do { sr_[i].vs0 = *reinterpret_cast<const bf16x8*>(&Vh[(long)((k0) + sr) * LDK + sc]); sr_[i].vs1 = *reinterpret_cast<const bf16x8*>(&Vh[(long)((k0) + 32 + sr) * LDK + sc]); \
    sr_[i].ks0 = *reinterpret_cast<const bf16x8*>(&Kh[(long)((k0) + sr) * LDK + sc]); sr_[i].ks1 = *reinterpret_cast<const bf16x8*>(&Kh[(long)((k0) + 32 + sr) * LDK + sc]); } while (0)
#define SWRITE(b, i) do { *(bf16x8*)((char*)V_lds + (b) * SHM_V + vst0) = sr_[i].vs0;          \
    *(bf16x8*)((char*)V_lds + (b) * SHM_V + vst1) = sr_[i].vs1; int kc = sc * 2;               \
    *(bf16x8*)((char*)K_lds + (b) * SHM_K + KSWZ(sr, kc)) = sr_[i].ks0;                       \
    *(bf16x8*)((char*)K_lds + (b) * SHM_K + KSWZ(32 + sr, kc)) = sr_[i].ks1; } while (0)
#define SWAIT() do { asm volatile("s_waitcnt vmcnt(4)" ::: "memory"); } while (0)
#define RESC(a) do { if (__any((a) < 1.f)) { if (hi == 0) al_l[r32] = (a); asm volatile("s_waitcnt lgkmcnt(0)" ::: "memory"); \
    for (int d = 0; d < 4; ++d) for (int r = 0; r < 16; ++r) o[d][r] *= al_l[crow(r, hi)]; } } while (0)
  f32x16 pA0, pA1, pB0, pB1; float mnA, mnB, alA, alB; bf16x8 pa0, pa1, pa2, pa3; const int NT = seq / KVBLK;
  constexpr int SE = 0, SO = SDEPTH - 1;
  SLOAD(SE, 0); asm volatile("s_waitcnt vmcnt(0)" ::: "memory"); SWRITE(0, SE); __syncthreads();
  qkt(pA0, pA1, K_lds, qr, r32, hi); partialSM(pA0, pA1, m_reg, mnA, alA);
  SLOAD(SO, KVBLK); if (2 < NT) SLOAD(SE, 2 * KVBLK);
  SWAIT(); SWRITE(1, SO); __syncthreads();
  for (int j = 1; j + 1 < NT; j += 2) {
    SBAR(); qkt(pB0, pB1, (bf16*)((char*)K_lds + SHM_K), qr, r32, hi);
    finishSM(pA0, pA1, alA, l_reg, pa0, pa1, pa2, pa3); SBAR();
    SLOAD(SO, (j + SDEPTH) * KVBLK); SBAR();
    pv_d0(o, vb0, pa0, pa1, pa2, pa3); partialSM(pB0, pB1, m_reg, mnB, alB);
    __syncthreads(); SWAIT(); SWRITE(0, SE);
    RESC(alB); __syncthreads();
    SBAR(); qkt(pA0, pA1, K_lds, qr, r32, hi);
    finishSM(pB0, pB1, alB, l_reg, pa0, pa1, pa2, pa3); SBAR();
    if (j + 3 < NT) SLOAD(SE, (j + 1 + SDEPTH) * KVBLK); SBAR();
    pv_d0(o, vb0 + (int)SHM_V, pa0, pa1, pa2, pa3); partialSM(pA0, pA1, m_reg, mnA, alA);
    __syncthreads(); SWAIT(); SWRITE(1, SO);
    RESC(alA); __syncthreads();
  }
  SBAR(); qkt(pB0, pB1, (bf16*)((char*)K_lds + SHM_K), qr, r32, hi);
  finishSM(pA0, pA1, alA, l_reg, pa0, pa1, pa2, pa3); SBAR();
  pv_d0(o, vb0, pa0, pa1, pa2, pa3); partialSM(pB0, pB1, m_reg, mnB, alB);
  __syncthreads(); RESC(alB);
  finishSM(pB0, pB1, alB, l_reg, pa0, pa1, pa2, pa3); SBAR();
  pv_d0(o, vb0 + (int)SHM_V, pa0, pa1, pa2, pa3);
  if (hi == 0) li_l[r32] = l_reg; asm volatile("s_waitcnt lgkmcnt(0)" ::: "memory");
  float rli[16];
#pragma unroll
  for (int r = 0; r < 16; ++r) rli[r] = __builtin_amdgcn_rcpf(li_l[crow(r, hi)]);
  bf16* Ow = Ob + (long)(wid * QBLK) * LDO;
#pragma unroll
  for (int r = 0; r < 16; ++r) { int orow = crow(r, hi);
    for (int d0 = 0; d0 < 4; ++d0) Ow[(long)orow * LDO + d0 * 32 + r32] = __float2bfloat16(o[d0][r] * rli[r]); }
#undef SLOAD
#undef SWRITE
#undef SWAIT
#undef RESC
}
#undef KSWZ
#undef SBAR
}
#define LAS __attribute__((address_space(3)))
typedef unsigned short bfu;
typedef short bf16x8 __attribute__((ext_vector_type(8)));
typedef float f32x4 __attribute__((ext_vector_type(4)));
typedef unsigned u32x4v __attribute__((ext_vector_type(4)));
typedef unsigned u32x2v __attribute__((ext_vector_type(2)));
using pg8::DM; using pg8::NBATCH; using pg8::SEQ; using pg8::CTXL; using pg8::RPB; using pg8::MR; using pg8::MH; using pg8::TPB; using pg8::HTILES; using pg8::FFD; using pg8::NMODW;
using pg8::bf2f; using pg8::cvt_pk_bf16; using pg8::fast_silu;
constexpr int NWAVES = 8, NTHR = 512, DEPTH = 4;
constexpr float EPS = 1e-6f;
constexpr int LDS_BYTES = 147456, LDS_CTL_OFF = 131072 + 64;
constexpr size_t al256(size_t x) { return (x + 255) / 256 * 256; }
constexpr size_t WS_BAR = 0, WS_BAR_BYTES = 16384;
constexpr size_t WS_MODS = WS_BAR_BYTES;
constexpr size_t WS_COSR = al256(WS_MODS + (size_t)DEPTH * 9 * NMODW * 4);
constexpr size_t WS_SINR = WS_COSR + (size_t)SEQ * 128 * 4;
constexpr size_t WS_COSRT = WS_SINR + (size_t)SEQ * 128 * 4;
constexpr size_t WS_SINRT = WS_COSRT + (size_t)SEQ * 128 * 4;
constexpr size_t WS_COSA = WS_SINRT + (size_t)SEQ * 128 * 4;
constexpr size_t WS_SINA = WS_COSA + (size_t)SEQ * 64 * 4;
constexpr size_t WS_X = WS_SINA + (size_t)SEQ * 64 * 4;
constexpr size_t WS_XN = WS_X + (size_t)MR * DM * 4;
constexpr size_t WS_W1A = WS_XN + (size_t)MR * DM * 2;
constexpr size_t WS_W2A = WS_W1A + (size_t)2 * FFD * DM * 2;
constexpr size_t WS_W1B = WS_W2A + (size_t)FFD * DM * 2;
constexpr size_t WS_W2B = WS_W1B + (size_t)2 * FFD * DM * 2;
constexpr size_t WS_WMIX = WS_W2B + (size_t)FFD * DM * 2;
constexpr size_t WMIX_QKG = 0, WMIX_KV = (size_t)4096 * DM * 2, WMIX_OUT = WMIX_KV + (size_t)3072 * DM * 2, WMIX_END = WMIX_OUT + (size_t)DM * 2048 * 2;
constexpr size_t WMIX_AQKV = 0, WMIX_AO = (size_t)1536 * DM * 2;
constexpr size_t WS_BIG = WS_WMIX + WMIX_END;
constexpr size_t BIG_QKG = 0, BIG_KVT = (size_t)MH * 4096 * 2, BIG_OF = BIG_KVT + (size_t)3072 * MH * 2, BIG_OB = BIG_OF + (size_t)MH * 2048 * 2, BIG_SP = BIG_OB + (size_t)MH * 2048 * 2,
                 BIG_RET_END = BIG_SP + (size_t)544 * 128 * 128 * 2;
constexpr size_t BIG_AQKV = 0, BIG_AO = (size_t)MR * 1536 * 2;
constexpr size_t BIG_H_END = (size_t)MR * FFD * 2;
constexpr size_t BIG_PART = (size_t)200 * 1048576, PART_KS = 11;
static_assert(BIG_PART >= BIG_H_END && BIG_PART + PART_KS * (size_t)NBATCH * CTXL * DM * 4 <= BIG_RET_END, "partial slabs inside BIG");
constexpr size_t WS_END = WS_BIG + (BIG_RET_END > BIG_H_END ? BIG_RET_END : BIG_H_END);

struct Args {
    const float *x, *c, *ctx, *c_ctx, *ada_w, *ada_b, *norm_g, *ffn_w1, *ffn_w2, *ret_w_in, *ret_w_out, *ret_dec_f, *ret_dec_b, *att_w_qkv, *att_w_o, *att_qg, *att_kg, *final_g;
    float* out; unsigned char* ws;
};

__device__ __forceinline__ float wave_sum(float v) {
#pragma unroll
    for (int o = 1; o < 64; o <<= 1) v += __shfl_xor(v, o);
    return v;
}
__device__ __forceinline__ unsigned f2bf(float f) { unsigned u = __builtin_bit_cast(unsigned, f); return (u + 0x7fffu + ((u >> 16) & 1u)) >> 16; }
__device__ __forceinline__ unsigned pk2(float lo, float hi) { return f2bf(lo) | (f2bf(hi) << 16); }
#define XB_TMO      128
#define XB_XCNT(j)  (256  + 64 * (j))
#define XB_XSUB(j)  (1280 + 64 * (j))
#define XB_XGEN(j)  (2304 + 64 * (j))
#define XB_TOP      3328
#define XB_TOPGEN   3392
#define XCD_BAR_WORDS 3456
#define XB_SPIN_CAP (1u << 18)

__device__ __forceinline__ unsigned xb_ld(unsigned* p)              { return __hip_atomic_load(p, __ATOMIC_RELAXED, __HIP_MEMORY_SCOPE_AGENT); }
__device__ __forceinline__ unsigned xb_add(unsigned* p, unsigned v) { return __hip_atomic_fetch_add(p, v, __ATOMIC_RELAXED, __HIP_MEMORY_SCOPE_AGENT); }
__device__ __forceinline__ unsigned xb_xcc_id() { return (unsigned)__builtin_amdgcn_s_getreg((3 << 11) | 20) & 0xFu; }
#define XB_SPIN(cond, bar) do { unsigned _sp = 0; while (cond) { __builtin_amdgcn_s_sleep(1); \
    if ((++_sp & 255u) == 0u) { if (xb_ld(&(bar)[XB_TMO])) break; if (_sp > XB_SPIN_CAP) { atomicAdd(&(bar)[XB_TMO], 1u); break; } } } } while (0)

struct XcdBarrier {
    unsigned* bar; unsigned x;
    volatile LAS unsigned* st;
};

__device__ __forceinline__ XcdBarrier xcd_barrier_post(unsigned* bar, volatile LAS unsigned* st) {
    XcdBarrier b; b.bar = bar; b.x = xb_xcc_id(); b.st = st;
    if (otid() == 0) (void)xb_add(&bar[XB_XCNT(b.x)], 1u);
    return b;
}
__device__ __forceinline__ void xcd_barrier_complete(unsigned* bar, unsigned x, unsigned& nloc, unsigned& nx) {
    const unsigned G = (unsigned)ogrid();
    unsigned sum, cnt, mine, sp = 0u;
    for (;;) {
        sum = 0u; cnt = 0u; mine = 0u;
#pragma unroll
        for (unsigned j = 0; j < 16; ++j) { const unsigned c = xb_ld(&bar[XB_XCNT(j)]); sum += c; cnt += (c > 0u) ? 1u : 0u; mine = (j == x) ? c : mine; }
        if (sum == G) break;
        __builtin_amdgcn_s_sleep(1);
        if ((++sp & 255u) == 0u) { if (xb_ld(&bar[XB_TMO])) break; if (sp > XB_SPIN_CAP) { atomicAdd(&bar[XB_TMO], 1u); break; } }
    }
    nloc = mine > 0u ? mine : 1u; nx = cnt > 0u ? cnt : 1u;
}

__device__ __forceinline__ void xcd_barrier(const XcdBarrier& b) {
    asm volatile("s_waitcnt vmcnt(0)" ::: "memory");
    __syncthreads();
    if (otid() == 0) {
        unsigned* bar = b.bar;
        __builtin_amdgcn_s_waitcnt(0);
        unsigned nloc = b.st[0], nx = b.st[1];
        if (nloc == 0u) { xcd_barrier_complete(bar, b.x, nloc, nx); b.st[0] = nloc; b.st[1] = nx; }
        const unsigned old = xb_add(&bar[XB_XSUB(b.x)], 1u);
        const unsigned gen = old / nloc;
        if (old + 1u == (gen + 1u) * nloc) {
            __builtin_amdgcn_fence(__ATOMIC_RELEASE, "agent");
            asm volatile("s_waitcnt vmcnt(0)" ::: "memory");
            const unsigned og = xb_add(&bar[XB_TOP], 1u);
            const unsigned tg = og / nx;
            if (og + 1u == (tg + 1u) * nx) xb_add(&bar[XB_TOPGEN], 1u);
            else XB_SPIN(xb_ld(&bar[XB_TOPGEN]) == tg, bar);
            __builtin_amdgcn_fence(__ATOMIC_ACQUIRE, "agent");
            xb_add(&bar[XB_XGEN(b.x)], 1u);
            asm volatile("s_waitcnt vmcnt(0)" ::: "memory");
        } else {
            XB_SPIN(xb_ld(&bar[XB_XGEN(b.x)]) == gen, bar);
            __builtin_amdgcn_fence(__ATOMIC_ACQUIRE, "agent");
            asm volatile("s_waitcnt vmcnt(0)" ::: "memory");
        }
    }
    __syncthreads();
}


__device__ __forceinline__ void transpose_item(const float* W, int K, int N, bfu* WT, int k0, int n0, int drow, float scale, LAS float* scr, int lane) {
#pragma unroll 8
    for (int i = 0; i < 32; ++i) { const int kk = 2 * i + (lane >> 5); scr[kk * 33 + (lane & 31)] = W[(size_t)(k0 + kk) * N + n0 + (lane & 31)] * scale; }
    asm volatile("s_waitcnt lgkmcnt(0)" ::: "memory");
    const int c = lane & 7;
#pragma unroll
    for (int j = 0; j < 4; ++j) { const int n = (lane >> 3) + 8 * j; const LAS float* s = scr + (8 * c) * 33 + n;
        u32x4v o; o.x = pk2(s[0 * 33], s[1 * 33]); o.y = pk2(s[2 * 33], s[3 * 33]); o.z = pk2(s[4 * 33], s[5 * 33]); o.w = pk2(s[6 * 33], s[7 * 33]);
        *(u32x4v*)(WT + (size_t)(drow + n) * K + k0 + 8 * c) = o; }
    asm volatile("s_waitcnt lgkmcnt(0)" ::: "memory");
}
__device__ __forceinline__ void conv_job(const float* W, int K, int N, int c0, int cnt, bfu* WT, int drow0, float scale, int mode, LAS float* scr, int lane, int gw, int NGW) {
    const int nblk = cnt / 32, nitems = (K / 64) * nblk;
    for (int it = gw; it < nitems; it += NGW) {
        const int kb = it / nblk, nb = it - kb * nblk; const int col = c0 + 32 * nb; int drow;
        if (mode == 0) drow = drow0 + 32 * nb;
        else { const int up = col >= FFD, j = up ? col - FFD : col; drow = 256 * (j >> 7) + (up ? 128 : 0) + (j & 127); }
        transpose_item(W, K, N, WT, 64 * kb, col, drow, scale, scr, lane);
    }
}
#define MFMA16(a, b, c) __builtin_amdgcn_mfma_f32_16x16x32_bf16((a), (b), (c), 0, 0, 0)

__device__ __forceinline__ void phase_ada_rope(const Args& a, unsigned char* ws, LAS unsigned char* lds) {
    const int tid = otid(), lane = tid & 63, wave = tid >> 6;
    LAS float* scs = (LAS float*)lds;
    LAS float* part = (LAS float*)(lds + 9 * 1024 * 4);
    for (int i = tid; i < 9 * 1024; i += NTHR) { const float v = (i < 8 * 1024) ? a.c[i] : a.c_ctx[i - 8 * 1024]; scs[i] = v / (1.0f + expf(-v)); }
    __syncthreads();
    float* mods = (float*)(ws + WS_MODS);
    for (int it = obid(); it < DEPTH * 144; it += ogrid()) {
        const int l = it / 144, cg0 = (it - l * 144) * 64, col = cg0 + lane;
        const float* wp = a.ada_w + ((size_t)l * DM + wave * 128) * NMODW + col;
        float acc[9];
#pragma unroll
        for (int r = 0; r < 9; ++r) acc[r] = 0.f;
        for (int k = 0; k < 128; k += 16) {
            float wv[16];
#pragma unroll
            for (int i = 0; i < 16; ++i) wv[i] = wp[(size_t)(k + i) * NMODW];
#pragma unroll
            for (int q = 0; q < 4; ++q)
#pragma unroll
                for (int r = 0; r < 9; ++r) { const f32x4 s = *(const LAS f32x4*)(scs + r * 1024 + wave * 128 + k + 4 * q); acc[r] += s[0] * wv[4 * q] + s[1] * wv[4 * q + 1] + s[2] * wv[4 * q + 2] + s[3] * wv[4 * q + 3]; }
        }
#pragma unroll
        for (int r = 0; r < 9; ++r) part[(wave * 9 + r) * 64 + lane] = acc[r];
        __syncthreads();
        for (int o = tid; o < 9 * 64; o += NTHR) { const int r = o >> 6, cc = o & 63; float s = 0.f;
#pragma unroll
            for (int w = 0; w < 8; ++w) s += part[(w * 9 + r) * 64 + cc];
            mods[((size_t)l * 9 + r) * NMODW + cg0 + cc] = s + a.ada_b[(size_t)l * NMODW + cg0 + cc]; }
        __syncthreads();
    }
    float* cosR = (float*)(ws + WS_COSR); float* sinR = (float*)(ws + WS_SINR); float* cosRT = (float*)(ws + WS_COSRT); float* sinRT = (float*)(ws + WS_SINRT);
    float* cosA = (float*)(ws + WS_COSA); float* sinA = (float*)(ws + WS_SINA);
    const int gt = obid() * NTHR + tid, NT = ogrid() * NTHR;
    const double TWO_PI = 6.283185307179586476925286766559, L2T = 13.287712379549449391481277717958;
    for (int i = gt; i < SEQ * 128; i += NT) { const int pos = i >> 7, j = i & 127;
        const double fr = exp2(-(double)j * (1.0 / 128.0) * L2T); double ang = (double)pos * fr; ang -= TWO_PI * rint(ang / TWO_PI);
        const float cs = cosf((float)ang), sn = sinf((float)ang);
        cosR[i] = cs; sinR[i] = sn; cosRT[(size_t)j * SEQ + pos] = cs; sinRT[(size_t)j * SEQ + pos] = sn; }
    for (int i = gt; i < SEQ * 64; i += NT) { const int pos = i >> 6, jj = i & 63;
        const double fr = exp2(-(double)(jj & 31) * (1.0 / 32.0) * L2T); const int pv = (jj < 32) ? (pos >> 6) : (pos & 63);
        double ang = (double)pv * fr; ang -= TWO_PI * rint(ang / TWO_PI);
        cosA[i] = cosf((float)ang); sinA[i] = sinf((float)ang); }
}

__device__ __forceinline__ void phase_conv_weights(const Args& a, unsigned char* ws, LAS unsigned char* lds, int L) {
    const int tid = otid(), lane = tid & 63, wave = tid >> 6; const int gw = obid() * NWAVES + wave, NGW = ogrid() * NWAVES;
    LAS float* scr = (LAS float*)(lds + wave * 16384);
    const float* w1 = a.ffn_w1 + (size_t)L * 2 * DM * 2 * FFD; const float* w2 = a.ffn_w2 + (size_t)L * 2 * FFD * DM;
    conv_job(w1, DM, 2 * FFD, 0, 2 * FFD, (bfu*)(ws + WS_W1A), 0, 1.f, 1, scr, lane, gw, NGW);
    conv_job(w1 + (size_t)DM * 2 * FFD, DM, 2 * FFD, 0, 2 * FFD, (bfu*)(ws + WS_W1B), 0, 1.f, 1, scr, lane, gw, NGW);
    conv_job(w2, FFD, DM, 0, DM, (bfu*)(ws + WS_W2A), 0, 1.f, 0, scr, lane, gw, NGW);
    conv_job(w2 + (size_t)FFD * DM, FFD, DM, 0, DM, (bfu*)(ws + WS_W2B), 0, 1.f, 0, scr, lane, gw, NGW);
    const int j = L >> 1;
    if ((L & 1) == 0) {
        const float* win = a.ret_w_in + (size_t)j * DM * 6144; const float* wout = a.ret_w_out + (size_t)j * 2048 * DM;
        bfu* qkg = (bfu*)(ws + WS_WMIX + WMIX_QKG); bfu* kv = (bfu*)(ws + WS_WMIX + WMIX_KV);
        conv_job(win, DM, 6144, 0, 1024, qkg, 0, 1.f, 0, scr, lane, gw, NGW);
        conv_job(win, DM, 6144, 1024, 1024, qkg, 1024, 0.0625f, 0, scr, lane, gw, NGW);
        conv_job(win, DM, 6144, 4096, 2048, qkg, 2048, 1.f, 0, scr, lane, gw, NGW);
        conv_job(win, DM, 6144, 1024, 1024, kv, 0, 0.0625f, 0, scr, lane, gw, NGW);
        conv_job(win, DM, 6144, 2048, 2048, kv, 1024, 1.f, 0, scr, lane, gw, NGW);
        conv_job(wout, 2048, DM, 0, DM, (bfu*)(ws + WS_WMIX + WMIX_OUT), 0, 1.f, 0, scr, lane, gw, NGW);
    } else {
        conv_job(a.att_w_qkv + (size_t)j * DM * 1536, DM, 1536, 0, 1536, (bfu*)(ws + WS_WMIX + WMIX_AQKV), 0, 1.f, 0, scr, lane, gw, NGW);
        conv_job(a.att_w_o + (size_t)j * DM * DM, DM, DM, 0, DM, (bfu*)(ws + WS_WMIX + WMIX_AO), 0, 1.f, 0, scr, lane, gw, NGW);
    }
}

__device__ __forceinline__ void phase_modnorm(const Args& a, unsigned char* ws, int L, int idx, bool first, int pend) {
    const int tid = otid(), lane = tid & 63, wave = tid >> 6; const int gw = obid() * NWAVES + wave, NGW = ogrid() * NWAVES;
    const float* mods = (const float*)(ws + WS_MODS) + (size_t)L * 9 * NMODW; const float* ng = a.norm_g + (size_t)(L * 3 + idx) * DM;
    float* X = (float*)(ws + WS_X); bfu* XN = (bfu*)(ws + WS_XN);
    for (int r = gw; r < MR; r += NGW) {
        const int b = r / RPB, t = r - b * RPB; const int mrow = (t >= SEQ) ? 8 : b;
        const float* src = first ? ((t < SEQ) ? a.x + ((size_t)b * SEQ + t) * DM : a.ctx + ((size_t)b * CTXL + (t - SEQ)) * DM) : X + (size_t)r * DM;
        f32x4 v[4]; float s = 0.f;
#pragma unroll
        for (int j = 0; j < 4; ++j) { v[j] = ((const f32x4*)src)[lane + 64 * j]; s += (v[j][0] * v[j][0] + v[j][1] * v[j][1]) + (v[j][2] * v[j][2] + v[j][3] * v[j][3]); }
        if (pend && t >= SEQ) {
            const float* gt = (const float*)(ws + WS_MODS) + (size_t)(pend == 1 ? L : L - 1) * 9 * NMODW + (size_t)8 * NMODW + (pend == 1 ? 2 : 8) * DM;
            const float* P = (const float*)(ws + WS_BIG + BIG_PART) + (size_t)(b * CTXL + (t - SEQ)) * DM; s = 0.f;
#pragma unroll
            for (int j = 0; j < 4; ++j) { f32x4 acc = (f32x4){0.f, 0.f, 0.f, 0.f};
#pragma unroll
                for (int ks = 0; ks < (int)PART_KS; ++ks) acc = acc + ((const f32x4*)(P + (size_t)ks * NBATCH * CTXL * DM))[lane + 64 * j];
                const f32x4 g4 = *(const f32x4*)(gt + 4 * lane + 256 * j);
                v[j] = v[j] + (g4 * 0.5f) * acc; s += (v[j][0] * v[j][0] + v[j][1] * v[j][1]) + (v[j][2] * v[j][2] + v[j][3] * v[j][3]); }
        }
        if (first || (pend && t >= SEQ)) {
#pragma unroll
            for (int j = 0; j < 4; ++j) ((f32x4*)(X + (size_t)r * DM))[lane + 64 * j] = v[j];
        }
        const float rstd = rsqrtf(wave_sum(s) * (1.0f / DM) + EPS);
        const float* sh = mods + (size_t)mrow * NMODW + (3 * idx) * DM; const float* sc = sh + DM;
#pragma unroll
        for (int j = 0; j < 4; ++j) { const int col = 4 * lane + 256 * j;
            const f32x4 g4 = *(const f32x4*)(ng + col), s4 = *(const f32x4*)(sc + col), h4 = *(const f32x4*)(sh + col);
            const f32x4 y = (v[j] * rstd) * g4 * (s4 + 1.0f) + h4;
            u32x2v w; w.x = pk2(y[0], y[1]); w.y = pk2(y[2], y[3]); *(u32x2v*)(XN + (size_t)r * DM + col) = w; }
    }
}
__device__ __forceinline__ void phase_final(const Args& a, unsigned char* ws) {
    const int tid = otid(), lane = tid & 63, wave = tid >> 6; const int gw = obid() * NWAVES + wave, NGW = ogrid() * NWAVES;
    const float* X = (const float*)(ws + WS_X);
    for (int q = gw; q < NBATCH * SEQ; q += NGW) {
        const int b = q / SEQ, t = q - b * SEQ; const float* src = X + ((size_t)b * RPB + t) * DM;
        f32x4 v[4]; float s = 0.f;
#pragma unroll
        for (int j = 0; j < 4; ++j) { v[j] = ((const f32x4*)src)[lane + 64 * j]; s += (v[j][0] * v[j][0] + v[j][1] * v[j][1]) + (v[j][2] * v[j][2] + v[j][3] * v[j][3]); }
        const float rstd = rsqrtf(wave_sum(s) * (1.0f / DM) + EPS);
#pragma unroll
        for (int j = 0; j < 4; ++j) { const int col = 4 * lane + 256 * j; const f32x4 g4 = *(const f32x4*)(a.final_g + col);
            *(f32x4*)(a.out + (size_t)q * DM + col) = (v[j] * rstd) * g4; }
    }
}

__device__ __forceinline__ void phase_qknorm(const Args& a, unsigned char* ws, int j) {
    const int tid = otid(), lane = tid & 63, wave = tid >> 6; const int gw = obid() * NWAVES + wave, NGW = ogrid() * NWAVES;
    bfu* QKV = (bfu*)(ws + WS_BIG + BIG_AQKV); const float* cosA = (const float*)(ws + WS_COSA); const float* sinA = (const float*)(ws + WS_SINA);
    const int sub = lane & 15;
    for (int it = gw * 4 + (lane >> 4); it < MR * 10; it += NGW * 4) {
        const int r = it / 10, hh = it - r * 10; const int b = r / RPB, t = r - b * RPB;
        bfu* p = QKV + (size_t)r * 1536 + hh * 128 + 8 * sub;
        const bf16x8 raw = *(const bf16x8*)p; float x[8]; float ss = 0.f;
#pragma unroll
        for (int i = 0; i < 8; ++i) { x[i] = bf2f((unsigned short)raw[i]); ss += x[i] * x[i]; }
        ss += __shfl_xor(ss, 1); ss += __shfl_xor(ss, 2); ss += __shfl_xor(ss, 4); ss += __shfl_xor(ss, 8);
        const float rstd = rsqrtf(ss * (1.0f / 128.0f) + EPS);
        const float* gn = ((hh < 8) ? a.att_qg : a.att_kg) + (size_t)j * 128 + 8 * sub;
#pragma unroll
        for (int i = 0; i < 8; ++i) x[i] = x[i] * rstd * gn[i];
        const bool lat = t < SEQ; const int jj = 8 * (sub & 7); const int tt = lat ? t : 0;
#pragma unroll
        for (int i = 0; i < 8; ++i) { const float other = __shfl_xor(x[i], 8); const float cs = cosA[(size_t)tt * 64 + jj + i], sn = sinA[(size_t)tt * 64 + jj + i];
            const float rot = (sub < 8) ? (x[i] * cs - other * sn) : (x[i] * cs + other * sn); x[i] = lat ? rot : x[i]; }
        u32x4v w; w.x = pk2(x[0], x[1]); w.y = pk2(x[2], x[3]); w.z = pk2(x[4], x[5]); w.w = pk2(x[6], x[7]);
        *(u32x4v*)p = w;
    }
}
__device__ __forceinline__ void phase_attention(unsigned char* ws, char* lds) {
    const attn::bf16* QKV = (const attn::bf16*)(ws + WS_BIG + BIG_AQKV); attn::bf16* AO = (attn::bf16*)(ws + WS_BIG + BIG_AO);
    for (int u = obid(); u < 1024 + 64; u += ogrid()) {
        int b, h, row0, key0, seq;
        if (u < 1024) { const int qb = u & 15; h = (u >> 4) & 7; b = u >> 7; row0 = b * RPB + qb * 256; key0 = b * RPB; seq = RPB; }
        else { const int v = u - 1024; h = v & 7; b = v >> 3; row0 = b * RPB + SEQ; key0 = b * RPB + SEQ; seq = CTXL; }
        const int kvh = h >> 2;
        attn::attn_dense_body(QKV + (size_t)row0 * 1536 + h * 128, QKV + (size_t)key0 * 1536 + 1024 + kvh * 128, QKV + (size_t)key0 * 1536 + 1280 + kvh * 128,
                              AO + (size_t)row0 * 1024 + h * 128, seq, lds);
        __syncthreads();
    }
}

__device__ __forceinline__ int ret_tok0(int bl, int cidx) { return bl * RPB + ((cidx < 32) ? 128 * cidx : SEQ + 128 * (cidx - 32)); }
__device__ __forceinline__ void phase_ret_sprime(const Args& a, unsigned char* ws, int j) {
    const int tid = otid(), lane = tid & 63, w = tid >> 6, r16 = lane & 15, quad = lane >> 4;
    const bfu* QKG = (const bfu*)(ws + WS_BIG + BIG_QKG); bfu* SP = (bfu*)(ws + WS_BIG + BIG_SP);
    for (int it = obid(); it < 544; it += ogrid()) {
        const int bh = it / 34, cidx = it - bh * 34, bl = bh >> 2, h = bh & 3; const int tok0 = ret_tok0(bl, cidx);
        const float l2f = -expf(a.ret_dec_f[j * 4 + h]) * 1.4426950408889634f, l2b = -expf(a.ret_dec_b[j * 4 + h]) * 1.4426950408889634f;
        const bfu* qp = QKG + (size_t)(tok0 + 16 * w + r16) * 4096 + 256 * h + 8 * quad;
        const bfu* kp = QKG + (size_t)(tok0 + r16) * 4096 + 1024 + 256 * h + 8 * quad;
        f32x4 acc[8];
#pragma unroll
        for (int mb = 0; mb < 8; ++mb) acc[mb] = (f32x4){0.f, 0.f, 0.f, 0.f};
#pragma unroll 2
        for (int ks = 0; ks < 8; ++ks) {
            const bf16x8 bq = *(const bf16x8*)(qp + 32 * ks);
#pragma unroll
            for (int mb = 0; mb < 8; ++mb) { const bf16x8 ak = *(const bf16x8*)(kp + (size_t)(16 * mb) * 4096 + 32 * ks); acc[mb] = MFMA16(ak, bq, acc[mb]); }
        }
        const int c = 16 * w + r16;
#pragma unroll
        for (int mb = 0; mb < 8; ++mb) { float v[4];
#pragma unroll
            for (int jj = 0; jj < 4; ++jj) { const int m = 16 * mb + 4 * quad + jj; const int d = c - m;
                const float mk = (d > 0) ? __builtin_amdgcn_exp2f((float)d * l2f) : ((d < 0) ? __builtin_amdgcn_exp2f((float)(-d) * l2b) : 2.0f); v[jj] = acc[mb][jj] * mk; }
            u32x2v o; o.x = cvt_pk_bf16(v[0], v[1]); o.y = cvt_pk_bf16(v[2], v[3]);
            *(u32x2v*)(SP + ((size_t)it * 128 + c) * 128 + 16 * mb + 4 * quad) = o; }
    }
}
constexpr int SROW = 264, KROW = 264, VROW = 136;
__device__ __forceinline__ int scan_cidx(int s, int dir) { return (s < 2) ? (dir ? (33 - s) : (32 + s)) : (dir ? (33 - s) : (s - 2)); }
__device__ __forceinline__ void phase_ret_scan(const Args& a, unsigned char* ws, LAS unsigned char* lds, int j) {
    const int tid = otid(), lane = tid & 63, w = tid >> 6, r16 = lane & 15, quad = lane >> 4;
    const bfu* QKG = (const bfu*)(ws + WS_BIG + BIG_QKG); const bfu* KVT = (const bfu*)(ws + WS_BIG + BIG_KVT);
    LAS bfu* SL = (LAS bfu*)lds; LAS bfu* KB = SL + 64 * SROW; LAS bfu* VB = KB + 64 * KROW;
    const int G_ = ogrid(), bx_ = obid(); const int vcu = ((G_ & 7) == 0) ? (bx_ & 7) * (G_ >> 3) + (bx_ >> 3) : bx_;
    for (int it = vcu; it < 256; it += G_) {
        const int es = it & 7, dir = (it >> 3) & 1, h = (it >> 4) & 3, bl = it >> 6;
        bfu* OD = (bfu*)(ws + WS_BIG + (dir ? BIG_OB : BIG_OF));
        const float l2f = -expf(a.ret_dec_f[j * 4 + h]) * 1.4426950408889634f, l2b = -expf(a.ret_dec_b[j * 4 + h]) * 1.4426950408889634f;
        const float l2g = dir ? l2b : l2f;
        const float gC = __builtin_amdgcn_exp2f(128.0f * l2g);
        const int cl = 16 * w + r16;
        const float xi = __builtin_amdgcn_exp2f((dir ? (float)(128 - cl) : (float)(cl + 1)) * l2g);
        float rp[8];
#pragma unroll
        for (int i = 0; i < 8; ++i) rp[i] = __builtin_amdgcn_exp2f((dir ? (float)i : (float)(-i)) * l2g);
        f32x4 st[4][2];
#pragma unroll
        for (int eb = 0; eb < 4; ++eb) { st[eb][0] = (f32x4){0.f, 0.f, 0.f, 0.f}; st[eb][1] = (f32x4){0.f, 0.f, 0.f, 0.f}; }
        for (int i = tid; i < 64 * SROW; i += NTHR) SL[i] = 0;
        const bfu* gkb = QKG + (size_t)(64 * dir + (tid >> 5)) * 4096 + 1024 + 256 * h + (tid & 31) * 8;
        const bfu* gvb = KVT + (size_t)(1024 + 512 * h + 64 * es + (tid >> 4)) * MH + (tid & 15) * 8;
        LAS bfu* kst = KB + (tid >> 5) * KROW + (tid & 31) * 8;  LAS bfu* vst = VB + (tid >> 4) * VROW + (tid & 15) * 8;
        const bfu* qb_ = QKG + (size_t)cl * 4096 + 256 * h + 8 * quad;
        const bfu* kTb = KVT + (size_t)(256 * h + 32 * w + r16) * MH + 8 * quad;
        bf16x8 bq[8], kr[4][2], gk[4], gv[2];
        {   const int tok = ret_tok0(bl, scan_cidx(0, dir));
#pragma unroll
            for (int p = 0; p < 4; ++p) gk[p] = *(const bf16x8*)(gkb + (size_t)(tok + 16 * p) * 4096);
#pragma unroll
            for (int p = 0; p < 2; ++p) gv[p] = *(const bf16x8*)(gvb + (size_t)(32 * p) * MH + tok);
#pragma unroll
            for (int ks = 0; ks < 8; ++ks) bq[ks] = *(const bf16x8*)(qb_ + (size_t)tok * 4096 + 32 * ks);
#pragma unroll
            for (int p = 0; p < 4; ++p) *(LAS bf16x8*)(kst + 16 * p * KROW) = gk[p];
#pragma unroll
            for (int p = 0; p < 2; ++p) *(LAS bf16x8*)(vst + 32 * p * VROW) = gv[p];
        }
        __syncthreads();
#pragma unroll 1
        for (int s = 0; s < 34; ++s) {
            const int tok0 = ret_tok0(bl, scan_cidx(s, dir)); const int tokn = ret_tok0(bl, scan_cidx(s < 33 ? s + 1 : s, dir));
#pragma unroll
            for (int ks = 0; ks < 4; ++ks) { kr[ks][0] = *(const bf16x8*)(kTb + tok0 + 32 * ks); kr[ks][1] = *(const bf16x8*)(kTb + (size_t)16 * MH + tok0 + 32 * ks); }
            __builtin_amdgcn_sched_barrier(0);
            f32x4 oa[4], sa[4];
#pragma unroll
            for (int eb = 0; eb < 4; ++eb) { oa[eb] = (f32x4){0.f, 0.f, 0.f, 0.f}; sa[eb] = (f32x4){0.f, 0.f, 0.f, 0.f}; }
            const LAS bfu* sl = SL + r16 * SROW + 8 * quad; const LAS bfu* kl = KB + r16 * KROW + 8 * quad; const LAS bfu* vl = VB + r16 * VROW;
#pragma unroll
            for (int ks = 0; ks < 8; ++ks) { bf16x8 fa[4], fk[4];
#pragma unroll
                for (int eb = 0; eb < 4; ++eb) { fa[eb] = *(const LAS bf16x8*)(sl + 16 * eb * SROW + 32 * ks); fk[eb] = *(const LAS bf16x8*)(kl + 16 * eb * KROW + 32 * ks); }
#pragma unroll
                for (int eb = 0; eb < 4; ++eb) { oa[eb] = MFMA16(fa[eb], bq[ks], oa[eb]); sa[eb] = MFMA16(fk[eb], bq[ks], sa[eb]); } }
#pragma unroll
            for (int ks = 0; ks < 8; ++ks) bq[ks] = *(const bf16x8*)(qb_ + (size_t)tokn * 4096 + 32 * ks);
#pragma unroll
            for (int p = 0; p < 4; ++p) gk[p] = *(const bf16x8*)(gkb + (size_t)(tokn + 16 * p) * 4096);
#pragma unroll
            for (int p = 0; p < 2; ++p) gv[p] = *(const bf16x8*)(gvb + (size_t)(32 * p) * MH + tokn);
#pragma unroll
            for (int eb = 0; eb < 4; ++eb) oa[eb] = oa[eb] * xi;
            unsigned sw2[4][2];
#pragma unroll
            for (int mb2 = 0; mb2 < 4; ++mb2) { float v[4];
#pragma unroll
                for (int jj = 0; jj < 4; ++jj) { const int m = 64 * dir + 16 * mb2 + 4 * quad + jj; const int d = cl - m;
                    const float mk = (d > 0) ? __builtin_amdgcn_exp2f((float)d * l2f) : ((d < 0) ? __builtin_amdgcn_exp2f((float)(-d) * l2b) : 2.0f); v[jj] = sa[mb2][jj] * mk; }
                sw2[mb2][0] = cvt_pk_bf16(v[0], v[1]); sw2[mb2][1] = cvt_pk_bf16(v[2], v[3]); }
#pragma unroll
            for (int kk = 0; kk < 2; ++kk) { u32x4v bw; bw.x = sw2[2 * kk][0]; bw.y = sw2[2 * kk][1]; bw.z = sw2[2 * kk + 1][0]; bw.w = sw2[2 * kk + 1][1];
                const bf16x8 bs = __builtin_bit_cast(bf16x8, bw);
#pragma unroll
                for (int eb = 0; eb < 4; ++eb) { const LAS bfu* vp = vl + 16 * eb * VROW + 64 * dir + 32 * kk + 4 * quad;
                    const u32x2v a0 = *(const LAS u32x2v*)vp, a1 = *(const LAS u32x2v*)(vp + 16);
                    u32x4v aw; aw.x = a0.x; aw.y = a0.y; aw.z = a1.x; aw.w = a1.y; oa[eb] = MFMA16(__builtin_bit_cast(bf16x8, aw), bs, oa[eb]); } }
            asm volatile("s_nop 15\n\ts_nop 7" : "+v"(oa[0]), "+v"(oa[1]), "+v"(oa[2]), "+v"(oa[3]));
            bfu* op = OD + (size_t)(tok0 + cl) * 2048 + 512 * h + 64 * es + 4 * quad;
#pragma unroll
            for (int eb = 0; eb < 4; ++eb) { u32x2v o; o.x = cvt_pk_bf16(oa[eb][0], oa[eb][1]); o.y = cvt_pk_bf16(oa[eb][2], oa[eb][3]); *(u32x2v*)(op + 16 * eb) = o; }
#pragma unroll
            for (int eb = 0; eb < 4; ++eb) { st[eb][0] = st[eb][0] * gC; st[eb][1] = st[eb][1] * gC; }
#pragma unroll
            for (int ks = 0; ks < 4; ++ks) { const int c0 = 32 * ks + 8 * quad;
                const float zb = __builtin_amdgcn_exp2f((dir ? (float)c0 : (float)(127 - c0)) * l2g);
                bf16x8 kz[2];
#pragma unroll
                for (int db = 0; db < 2; ++db) { float z[8];
#pragma unroll
                    for (int i = 0; i < 8; ++i) z[i] = bf2f((unsigned short)kr[ks][db][i]) * (zb * rp[i]);
                    u32x4v kw; kw.x = cvt_pk_bf16(z[0], z[1]); kw.y = cvt_pk_bf16(z[2], z[3]); kw.z = cvt_pk_bf16(z[4], z[5]); kw.w = cvt_pk_bf16(z[6], z[7]);
                    kz[db] = __builtin_bit_cast(bf16x8, kw); }
#pragma unroll
                for (int eb = 0; eb < 4; ++eb) { const bf16x8 vfr = *(const LAS bf16x8*)(vl + 16 * eb * VROW + 32 * ks + 8 * quad);
                    st[eb][0] = MFMA16(vfr, kz[0], st[eb][0]); st[eb][1] = MFMA16(vfr, kz[1], st[eb][1]); } }
            asm volatile("s_waitcnt lgkmcnt(0)" ::: "memory"); __builtin_amdgcn_s_barrier(); asm volatile("" ::: "memory");
#pragma unroll
            for (int eb = 0; eb < 4; ++eb)
#pragma unroll
                for (int db = 0; db < 2; ++db)
#pragma unroll
                    for (int jj = 0; jj < 4; ++jj) SL[(16 * eb + 4 * quad + jj) * SROW + 32 * w + 16 * db + r16] = (bfu)f2bf(st[eb][db][jj]);
#pragma unroll
            for (int p = 0; p < 4; ++p) *(LAS bf16x8*)(kst + 16 * p * KROW) = gk[p];
#pragma unroll
            for (int p = 0; p < 2; ++p) *(LAS bf16x8*)(vst + 32 * p * VROW) = gv[p];
            asm volatile("s_waitcnt lgkmcnt(0)" ::: "memory"); __builtin_amdgcn_s_barrier(); asm volatile("" ::: "memory");
        }
        __syncthreads();
    }
}
__device__ __forceinline__ void phase_ret_merge(unsigned char* ws) {
    const int tid = otid(), lane = tid & 63, wave = tid >> 6; const int gw = obid() * NWAVES + wave, NGW = ogrid() * NWAVES;
    bfu* OF = (bfu*)(ws + WS_BIG + BIG_OF); const bfu* OB = (const bfu*)(ws + WS_BIG + BIG_OB); const bfu* QKG = (const bfu*)(ws + WS_BIG + BIG_QKG);
    for (int it = gw; it < MH * 4; it += NGW) {
        const int r = it >> 2, h = it & 3; const size_t off = (size_t)r * 2048 + 512 * h + 8 * lane;
        const bf16x8 f = *(const bf16x8*)(OF + off), b = *(const bf16x8*)(OB + off), g = *(const bf16x8*)(QKG + (size_t)r * 4096 + 2048 + 512 * h + 8 * lane);
        float o[8]; float ss = 0.f;
#pragma unroll
        for (int i = 0; i < 8; ++i) { o[i] = bf2f((unsigned short)f[i]) + bf2f((unsigned short)b[i]); ss += o[i] * o[i]; }
        const float rstd = rsqrtf(wave_sum(ss) * (1.0f / 512.0f) + EPS);
#pragma unroll
        for (int i = 0; i < 8; ++i) o[i] = o[i] * rstd * bf2f((unsigned short)g[i]);
        u32x4v w; w.x = pk2(o[0], o[1]); w.y = pk2(o[2], o[3]); w.z = pk2(o[4], o[5]); w.w = pk2(o[6], o[7]);
        *(u32x4v*)(OF + off) = w;
    }
}
typedef const __attribute__((address_space(4))) Args* KArgs;
__device__ __forceinline__ Args kargs() {
#if defined(__HIP_DEVICE_COMPILE__)
    KArgs p = (KArgs)__builtin_amdgcn_kernarg_segment_ptr(); asm volatile("" : "+s"(p)); return *p;
#else
    return Args{};
#endif
}
#define KA() const Args a = kargs(); unsigned char* const ws = a.ws; (void)ws
__global__ void __launch_bounds__(NTHR, 2) fwd_kernel(Args a_unused) {
    extern __shared__ __attribute__((aligned(16))) unsigned char lds_raw[];
    cg::grid_group grid = cg::this_grid();
    LAS unsigned char* lds = (LAS unsigned char*)lds_raw;
#ifndef PHM
#define PHM 0xFFFFFFFFu
#endif
#define PH(n) if ((PHM >> (n)) & 1u)
#define GSYNC_CG() do { asm volatile("s_waitcnt vmcnt(0) lgkmcnt(0)" ::: "memory"); grid.sync(); asm volatile("" ::: "memory"); } while (0)
#define GSYNC() do { for (int rs_ = 0; rs_ < REP_SYNC; ++rs_) { KA(); XcdBarrier xb_; xb_.bar = (unsigned*)(ws + WS_BAR); xb_.x = xb_xcc_id(); xb_.st = (volatile LAS unsigned*)(lds + LDS_CTL_OFF); xcd_barrier(xb_); asm volatile("" ::: "memory"); } } while (0)
#ifndef REP_SCAN
#define REP_SCAN 1
#endif
#ifndef REP_ATT
#define REP_ATT 1
#endif
#ifndef REP_W1
#define REP_W1 1
#endif
#ifndef REP_MN
#define REP_MN 1
#endif
#ifndef REP_CONV
#define REP_CONV 1
#endif
#ifndef REP_INP
#define REP_INP 1
#endif
#ifndef REP_ADA
#define REP_ADA 1
#endif
#ifndef REP_W2
#define REP_W2 1
#endif
#ifndef REP_SYNC
#define REP_SYNC 1
#endif
#define XP ((float*)(ws + WS_X))
#define XNP ((const bfu*)(ws + WS_XN))
#define MODSL ((const float*)(ws + WS_MODS) + (size_t)L * 9 * NMODW)
    if (otid() < 4) ((volatile LAS unsigned*)(lds + LDS_CTL_OFF))[otid()] = 0u;
    __syncthreads();
    { KA(); (void)xcd_barrier_post((unsigned*)(ws + WS_BAR), (volatile LAS unsigned*)(lds + LDS_CTL_OFF)); }
    PH(0) for (int rep = 0; rep < REP_ADA; ++rep) { KA(); phase_ada_rope(a, ws, lds); __syncthreads(); }
#pragma unroll 1
    for (int L = 0; L < DEPTH; ++L) {
        __syncthreads();
        PH(1) for (int rep = 0; rep < REP_CONV; ++rep) { KA(); phase_conv_weights(a, ws, lds, L); __syncthreads(); }
        if (L == 0) GSYNC_CG();
#pragma unroll 1
        for (int s = 0; s < 2; ++s) {
            PH(2) for (int rep = 0; rep < REP_MN; ++rep) { KA(); phase_modnorm(a, ws, L, s ? 2 : 0, (L == 0) && (s == 0), (s == 0 && L > 0) ? 2 : 0); }
            GSYNC();
            PH(3) for (int rep = 0; rep < REP_W1; ++rep) {   KA();
                pg8::Gemm g{XNP, (const bfu*)(ws + (s ? WS_W1B : WS_W1A)), MR, 2 * FFD, DM, DM}; pg8::StaticOrder S; S.init(MR, 2 * FFD, ogrid(), obid());
                pg8::EpiSwiglu E{(bfu*)(ws + WS_BIG)};
                pg8::gemm_phase<pg8::EpiSwiglu, pg8::StaticOrder, true, true>(lds, g, S, E);
            }
            GSYNC();
            PH(4) for (int rep = 0; rep < REP_W2; ++rep) {   KA();
                {   pg8::Gemm g{(const bfu*)(ws + WS_BIG), (const bfu*)(ws + (s ? WS_W2B : WS_W2A)), MR, DM, FFD, FFD}; pg8::LatentOrder S; S.init(MR / 256, DM, ogrid(), obid());
                    pg8::EpiResid E{XP, MODSL + (s ? 8 : 2) * DM, 0.5f / REP_W2, 0};
                    pg8::gemm_phase<pg8::EpiResid, pg8::LatentOrder, true, true>(lds, g, S, E); }
                if (!(s && L == DEPTH - 1)) {
                    pg8::Gemm g{(const bfu*)(ws + WS_BIG), (const bfu*)(ws + (s ? WS_W2B : WS_W2A)), MR, DM, FFD, 256}; pg8::CtxSplitOrder S; S.init(MR / 256, DM, FFD, 256, ogrid(), obid());
                    pg8::EpiPartial E{(float*)(ws + WS_BIG + BIG_PART), 512, NBATCH * CTXL};
                    pg8::gemm_phase<pg8::EpiPartial, pg8::CtxSplitOrder, true, true>(lds, g, S, E); }
            }
            GSYNC();
            if (s == 0) {
                PH(2) for (int rep = 0; rep < REP_MN; ++rep) { KA(); phase_modnorm(a, ws, L, 1, false, 1); }
                GSYNC();
                if ((L & 1) == 0) {
#pragma unroll 1
                    for (int hf = 0; hf < 2; ++hf) {
                        PH(5) for (int rep = 0; rep < REP_INP; ++rep) {   KA(); pg8::Gemm g{XNP + (size_t)hf * MH * DM, (const bfu*)(ws + WS_WMIX + WMIX_QKG), MH, 4096, DM, DM}; pg8::StaticOrder S; S.init(MH, 4096, ogrid(), obid());
                            pg8::EpiRetQKG E{(bfu*)(ws + WS_BIG + BIG_QKG), (const float*)(ws + WS_COSR), (const float*)(ws + WS_SINR), hf * HTILES};
                            pg8::gemm_phase<pg8::EpiRetQKG, pg8::StaticOrder, true, true>(lds, g, S, E); }
                        PH(6) for (int rep = 0; rep < REP_INP; ++rep) {   KA(); pg8::Gemm g{(const bfu*)(ws + WS_WMIX + WMIX_KV), XNP + (size_t)hf * MH * DM, 3072, MH, DM, DM}; pg8::StaticOrder S; S.init(3072, MH, ogrid(), obid());
                            pg8::EpiRetKVT E{(bfu*)(ws + WS_BIG + BIG_KVT), (const float*)(ws + WS_COSRT), (const float*)(ws + WS_SINRT), hf * HTILES};
                            pg8::gemm_phase<pg8::EpiRetKVT, pg8::StaticOrder, true, true>(lds, g, S, E); }
                        GSYNC();
                        PH(8) for (int rep = 0; rep < REP_SCAN; ++rep) { KA(); phase_ret_scan(a, ws, lds, L >> 1); }
                        GSYNC();
                        PH(9) { KA(); phase_ret_merge(ws); }
                        GSYNC();
                        PH(10) {   KA(); pg8::Gemm g{(const bfu*)(ws + WS_BIG + BIG_OF), (const bfu*)(ws + WS_WMIX + WMIX_OUT), MH, DM, 2048, 2048}; pg8::StaticOrder S; S.init(MH, DM, ogrid(), obid());
                            pg8::EpiResid E{XP, MODSL + 5 * DM, 1.0f, hf * HTILES};
                            pg8::gemm_phase<pg8::EpiResid, pg8::StaticOrder, true, true>(lds, g, S, E); }
                        GSYNC();
                    }
                } else {
                    PH(11) {   KA(); pg8::Gemm g{XNP, (const bfu*)(ws + WS_WMIX + WMIX_AQKV), MR, 1536, DM, DM}; pg8::StaticOrder S; S.init(MR, 1536, ogrid(), obid());
                        pg8::EpiPlain E{(bfu*)(ws + WS_BIG + BIG_AQKV), 1536};
                        pg8::gemm_phase<pg8::EpiPlain, pg8::StaticOrder, true, true>(lds, g, S, E); }
                    GSYNC();
                    PH(12) { KA(); phase_qknorm(a, ws, L >> 1); }
                    GSYNC();
                    PH(13) for (int rep = 0; rep < REP_ATT; ++rep) { KA(); phase_attention(ws, (char*)lds_raw); }
                    GSYNC();
                    PH(14) {   KA(); pg8::Gemm g{(const bfu*)(ws + WS_BIG + BIG_AO), (const bfu*)(ws + WS_WMIX + WMIX_AO), MR, DM, DM, DM}; pg8::StaticOrder S; S.init(MR, DM, ogrid(), obid());
                        pg8::EpiResid E{XP, MODSL + 5 * DM, 1.0f, 0};
                        pg8::gemm_phase<pg8::EpiResid, pg8::StaticOrder, true, true>(lds, g, S, E); }
                    GSYNC();
                }
            }
        }
    }
    PH(15) { KA(); phase_final(a, ws); }
}

extern "C" void kernel_launch(void* const* d_in, const int* in_sizes, int n_in, void* d_out, int out_size, void* d_ws, size_t ws_size, hipStream_t stream) {
    static int grid = 0;
    if (grid == 0) {
        if (n_in != 18 || out_size != NBATCH * SEQ * DM || ws_size < WS_END) { fprintf(stderr, "kernel_launch: unexpected shapes: n_in %d out %d ws %zu (need %zu)\n", n_in, out_size, ws_size, (size_t)WS_END); grid = -1; return; }
        int dev = 0, cus = 0;
        if (hipGetDevice(&dev) != hipSuccess || hipDeviceGetAttribute(&cus, hipDeviceAttributeMultiprocessorCount, dev) != hipSuccess) { grid = -1; return; }
        if (hipFuncSetAttribute((const void*)fwd_kernel, hipFuncAttributeMaxDynamicSharedMemorySize, LDS_BYTES) != hipSuccess) { fprintf(stderr, "kernel_launch: hipFuncSetAttribute failed\n"); grid = -1; return; }
        int per = 0;
        if (hipOccupancyMaxActiveBlocksPerMultiprocessor(&per, (const void*)fwd_kernel, NTHR, LDS_BYTES) != hipSuccess || per < 1) fprintf(stderr, "kernel_launch: occupancy query says %d\n", per);
        (void)hipGetLastError();
        grid = cus;
    }
    if (grid < 0) return;
    if (hipMemsetAsync((char*)d_ws + WS_BAR, 0, WS_BAR_BYTES, stream) != hipSuccess) { fprintf(stderr, "kernel_launch: memset of the barrier words failed\n"); return; }
    Args a{};
    const float** ap = (const float**)&a;
    for (int i = 0; i < 18; ++i) ap[i] = (const float*)d_in[i];
    a.out = (float*)d_out; a.ws = (unsigned char*)d_ws;
    void* args[] = {&a};
    hipError_t e = hipLaunchCooperativeKernel((const void*)fwd_kernel, dim3(grid), dim3(NTHR), args, LDS_BYTES, stream);
    if (e != hipSuccess) fprintf(stderr, "kernel_launch: cooperative launch failed: %s (grid %d)\n", hipGetErrorString(e), grid);
}
```
